# Optimizing an MI355X kernel written in HIP

```python
import math
import jax
import jax.numpy as jnp
from jax import lax
import numpy as np

D_MODEL = 1024
BATCH = 32
SEQ = 256
DEPTH = 4
DEC_BATCH = 8
DEC_SEQ = 1024
PAST_LEN = 512

GRID_W = 64
EPS = 1e-6
N_EVEN = (DEPTH + 1) // 2
N_ODD = DEPTH // 2
SSD_HEADS = 16
SSD_HEAD_DIM = 64
D_SSD = SSD_HEADS * SSD_HEAD_DIM
SSD_GROUPS = 2
SSD_STATE = 64
SSD_CONV_W = 4
SSD_CHUNK = 128
SSD_CONV_CH = D_SSD + 2 * SSD_GROUPS * SSD_STATE
ATT_HEADS = 8
ATT_HALF_DIM = 64
ATT_V_DIM = 2 * ATT_HALF_DIM
D_ATT = ATT_HEADS * ATT_V_DIM
Q_BLOCK = 128
ROPE_THETA = 10000.0
AXIS_ROT_DIM = ATT_HALF_DIM // 2
D_RNN = 1024
RNN_BLOCKS = 16
RNN_BLOCK_W = D_RNN // RNN_BLOCKS
RNN_CONV_W = 4
RG_C = 8.0
D_FF = 2816
FFN_CONV_W = 3
D_IN_EVEN = D_SSD + SSD_CONV_CH + 2 * SSD_HEADS + 3 * D_ATT
D_IN_ODD = 2 * D_RNN

kernel_name = 'hybrid_ssd_diffattn_rglru_dit_step'


def rmsnorm(x, g):
    xf = x.astype(jnp.float32)
    y = xf * lax.rsqrt(jnp.mean(xf * xf, axis=-1, keepdims=True) + EPS)
    return (y * g.astype(jnp.float32)).astype(x.dtype)


def modulate(h, shift, scale):
    return h * (1.0 + scale) + shift


def ada_params(cvec, w_mod, b_mod):
    m = jax.nn.silu(cvec) @ w_mod + b_mod
    return jnp.split(m[:, None, :], 6, axis=-1)


def dwconv_centred(x, w, b):
    width = w.shape[0]
    left = width // 2
    right = width - 1 - left
    n = x.shape[1]
    xp = jnp.pad(x, ((0, 0), (left, right), (0, 0)))
    y = xp[:, 0:n] * w[0]
    for k in range(1, width):
        y = y + xp[:, k:k + n] * w[k]
    return y + b


def axial_rope_tables(n, dtype):
    rows = n // GRID_W
    row = jnp.repeat(jnp.arange(rows, dtype=jnp.float32), GRID_W)
    col = jnp.tile(jnp.arange(GRID_W, dtype=jnp.float32), rows)
    freqs = ROPE_THETA ** (-jnp.arange(0, AXIS_ROT_DIM, 2, dtype=jnp.float32) / AXIS_ROT_DIM)

    def tab(pos):
        ang = (pos[:, None] * freqs)[:, None, None, :]
        return jnp.cos(ang).astype(dtype), jnp.sin(ang).astype(dtype)

    cos_r, sin_r = tab(row)
    cos_c, sin_c = tab(col)
    return (cos_r, sin_r, cos_c, sin_c)


def rope_half(x, cos, sin):
    x1, x2 = jnp.split(x, 2, axis=-1)
    return jnp.concatenate([x1 * cos - x2 * sin, x1 * sin + x2 * cos], axis=-1)


def apply_axial_rope(x, tables):
    cos_r, sin_r, cos_c, sin_c = tables
    x_row, x_col = jnp.split(x, 2, axis=-1)
    return jnp.concatenate([rope_half(x_row, cos_r, sin_r), rope_half(x_col, cos_c, sin_c)], axis=-1)


def diff_attention(q, k, v, lam):
    b, nq, nh = q.shape[0], q.shape[1], q.shape[2]
    nb = nq // Q_BLOCK
    scale = ATT_HALF_DIM ** -0.5
    qb = jnp.moveaxis(q.reshape(b, nb, Q_BLOCK, nh, 2, ATT_HALF_DIM), 1, 0)

    def block(qi):
        s = jnp.einsum('bqhcd,bkhcd->bhcqk', qi, k, preferred_element_type=jnp.float32) * scale
        p = jax.nn.softmax(s, axis=-1)
        pd = (p[:, :, 0] - lam * p[:, :, 1]).astype(v.dtype)
        return jnp.einsum('bhqk,bkhe->bqhe', pd, v)

    o = lax.map(block, qb)
    return jnp.moveaxis(o, 0, 1).reshape(b, nq, nh, v.shape[-1])


def ssd_chunk_scan(x, dt, a, bm, cm, h0):
    f32 = jnp.float32
    b, n, nh, p = x.shape
    g, ns = bm.shape[2], bm.shape[3]
    hg = nh // g
    nc = n // SSD_CHUNK
    xc = x.reshape(b, nc, SSD_CHUNK, g, hg, p).astype(f32)
    dtc = dt.reshape(b, nc, SSD_CHUNK, g, hg)
    bc = bm.reshape(b, nc, SSD_CHUNK, g, ns).astype(f32)
    cc = cm.reshape(b, nc, SSD_CHUNK, g, ns).astype(f32)
    acs = jnp.cumsum(dtc * a.reshape(g, hg), axis=2)
    seg = acs[:, :, :, None] - acs[:, :, None, :]
    tril = jnp.tril(jnp.ones((SSD_CHUNK, SSD_CHUNK), dtype=bool))[:, :, None, None]
    lmat = jnp.exp(jnp.where(tril, seg, -jnp.inf))
    xdt = xc * dtc[..., None]
    cb = jnp.einsum('bcqgn,bckgn->bcqkg', cc, bc)
    y_diag = jnp.einsum('bcqkg,bcqkgh,bckghp->bcqghp', cb, lmat, xdt)
    decay_end = jnp.exp(acs[:, :, -1:] - acs)
    states = jnp.einsum('bckgn,bckgh,bckghp->bcghpn', bc, decay_end, xdt)
    chunk_decay = jnp.exp(acs[:, :, -1])

    def step(h, inp):
        dec, st = inp
        return dec[..., None, None] * h + st, h

    h_fin, prev = lax.scan(step, h0.reshape(b, g, hg, p, ns).astype(f32),
                           (jnp.moveaxis(chunk_decay, 1, 0), jnp.moveaxis(states, 1, 0)))
    prev = jnp.moveaxis(prev, 0, 1)
    y_off = jnp.einsum('bcqgn,bcghpn,bcqgh->bcqghp', cc, prev, jnp.exp(acs))
    y = (y_diag + y_off).reshape(b, n, nh, p).astype(x.dtype)
    return y, h_fin.reshape(b, nh, p, ns).astype(h0.dtype)


def ssd_bidirectional(xs, dt_raw, bm, cm, a_log, dt_bias, h0f, h0b):
    f32 = jnp.float32

    def flip(t):
        return jnp.flip(t, axis=1)

    a = -jnp.exp(a_log.astype(f32))
    dt_f = jax.nn.softplus(dt_raw[..., :SSD_HEADS].astype(f32) + dt_bias[0].astype(f32))
    dt_b = jax.nn.softplus(dt_raw[..., SSD_HEADS:].astype(f32) + dt_bias[1].astype(f32))
    y_f, h_f = ssd_chunk_scan(xs, dt_f, a[0], bm, cm, h0f)
    y_b, h_b = ssd_chunk_scan(flip(xs), flip(dt_b), a[1], flip(bm), flip(cm), h0b)
    return y_f + flip(y_b), h_f, h_b


def linear_scan(a, u, h0):
    u = u.at[:, 0].add(a[:, 0] * h0)

    def combine(lo, hi):
        return (lo[0] * hi[0], hi[0] * lo[1] + hi[1])

    _, h = lax.associative_scan(combine, (a, u), axis=1)
    return h, h[:, -1]


def rglru_direction(xr, wa, ba, wx, bx, lam, h0, reverse):
    f32 = jnp.float32
    b, n, _ = xr.shape
    xb = xr.reshape(b, n, RNN_BLOCKS, RNN_BLOCK_W)
    r = jax.nn.sigmoid(jnp.einsum('blnk,nkj->blnj', xb, wa).reshape(b, n, D_RNN) + ba)
    i = jax.nn.sigmoid(jnp.einsum('blnk,nkj->blnj', xb, wx).reshape(b, n, D_RNN) + bx)
    log_a = -RG_C * r.astype(f32) * jax.nn.softplus(-lam.astype(f32))
    a = jnp.exp(log_a)
    u = jnp.sqrt(-jnp.expm1(2.0 * log_a)) * (i * xr).astype(f32)
    if reverse:
        a, u = jnp.flip(a, axis=1), jnp.flip(u, axis=1)
    hseq, hlast = linear_scan(a, u, h0.astype(f32))
    if reverse:
        hseq = jnp.flip(hseq, axis=1)
    return hseq.astype(xr.dtype), hlast.astype(h0.dtype)


def even_mixer(h, w_in, conv_w, conv_b, a_log, dt_bias, d_skip, norm_g, lam_p, sub_g, w_out,
               lam_init, rope, ctx):
    b, n, _ = h.shape
    gn = SSD_GROUPS * SSD_STATE
    c1 = D_SSD
    c2 = c1 + SSD_CONV_CH
    c3 = c2 + 2 * SSD_HEADS
    c4 = c3 + D_ATT
    c5 = c4 + D_ATT
    z, xbc, dt_raw, q, k, v = jnp.split(h @ w_in, [c1, c2, c3, c4, c5], axis=-1)
    xbc = jax.nn.silu(dwconv_centred(xbc, conv_w, conv_b))
    xs, bm, cm = jnp.split(xbc, [D_SSD, D_SSD + gn], axis=-1)
    xs = xs.reshape(b, n, SSD_HEADS, SSD_HEAD_DIM)
    bm = bm.reshape(b, n, SSD_GROUPS, SSD_STATE)
    cm = cm.reshape(b, n, SSD_GROUPS, SSD_STATE)
    if ctx is None:
        h0f = jnp.zeros((b, SSD_HEADS, SSD_HEAD_DIM, SSD_STATE), h.dtype)
        h0b = h0f
    else:
        h0f, h0b = ctx[2], ctx[3]
    y, hf, hb = ssd_bidirectional(xs, dt_raw, bm, cm, a_log, dt_bias, h0f, h0b)
    y = y + d_skip[:, None] * xs
    y = rmsnorm(y.reshape(b, n, D_SSD) * jax.nn.silu(z), norm_g)
    q = q.reshape(b, n, ATT_HEADS, 2, ATT_HALF_DIM)
    k = k.reshape(b, n, ATT_HEADS, 2, ATT_HALF_DIM)
    v = v.reshape(b, n, ATT_HEADS, ATT_V_DIM)
    lp = lam_p.astype(jnp.float32)
    lam = jnp.exp(jnp.sum(lp[0] * lp[1])) - jnp.exp(jnp.sum(lp[2] * lp[3])) + lam_init
    if ctx is None:
        o = diff_attention(q, k, v, lam)
    else:
        q = apply_axial_rope(q, rope)
        k = apply_axial_rope(k, rope)
        o = diff_attention(q, jnp.concatenate([ctx[0], k], axis=1),
                           jnp.concatenate([ctx[1], v], axis=1), lam)
    o = rmsnorm(o, sub_g) * (1.0 - lam_init)
    out = jnp.concatenate([y, o.reshape(b, n, D_ATT)], axis=-1) @ w_out
    return out, (k, v, hf, hb)


def odd_mixer(h, w_in, conv_w, conv_b, wa, ba, wx, bx, lam, w_out, ctx):
    b = h.shape[0]
    gate, xr = jnp.split(h @ w_in, 2, axis=-1)
    xr = dwconv_centred(xr, conv_w, conv_b)
    if ctx is None:
        h0f = jnp.zeros((b, D_RNN), h.dtype)
        h0b = h0f
    else:
        h0f, h0b = ctx
    yf, hf = rglru_direction(xr, wa[0], ba[0], wx[0], bx[0], lam[0], h0f, False)
    yb, hb = rglru_direction(xr, wa[1], ba[1], wx[1], bx[1], lam[1], h0b, True)
    y = (yf + yb) * jax.nn.gelu(gate)
    return y @ w_out, (hf, hb)


def conv_ffn(h, w_up, conv_w, conv_b, w_down):
    u = dwconv_centred(h @ w_up, conv_w, conv_b)
    val, g = jnp.split(u, 2, axis=-1)
    return (jax.nn.silu(g) * val) @ w_down


def setup_inputs(seed: int = 0) -> dict:
    key = jax.random.key(seed)
    keys = iter(jax.random.split(key, 48))
    f32 = jnp.float32
    D = D_MODEL
    ne, no = N_EVEN, N_ODD

    def nrm(shape, scale):
        return jax.random.normal(next(keys), shape, f32) * scale

    def unif(shape, lo, hi):
        return jax.random.uniform(next(keys), shape, f32, lo, hi)

    dt0 = jnp.exp(unif((ne, 2, SSD_HEADS), math.log(1e-3), math.log(1e-1)))
    a_lru = unif((no, 2, D_RNN), 0.9, 0.999) ** (1.0 / RG_C)
    return {
        'x_prompt': nrm((BATCH, SEQ, D), 1.0),
        'x_sample': nrm((DEC_BATCH, DEC_SEQ, D), 1.0),
        'c': nrm((DEC_BATCH, D), 1.0),
        'cache_attn_k': nrm((DEC_BATCH, ne, PAST_LEN, ATT_HEADS, 2, ATT_HALF_DIM), 1.0),
        'cache_attn_v': nrm((DEC_BATCH, ne, PAST_LEN, ATT_HEADS, ATT_V_DIM), 1.0),
        'state_ssd_fwd': nrm((DEC_BATCH, ne, SSD_HEADS, SSD_HEAD_DIM, SSD_STATE), 0.5),
        'state_ssd_bwd': nrm((DEC_BATCH, ne, SSD_HEADS, SSD_HEAD_DIM, SSD_STATE), 0.5),
        'state_lru_fwd': nrm((DEC_BATCH, no, D_RNN), 0.5),
        'state_lru_bwd': nrm((DEC_BATCH, no, D_RNN), 0.5),
        'c_ctx': nrm((D,), 1.0),
        'w_mod': nrm((DEPTH, D, 6 * D), 0.5 * D ** -0.5),
        'b_mod': nrm((DEPTH, 6 * D), 0.02),
        'norm_mix_g': 1.0 + nrm((DEPTH, D), 0.02),
        'norm_ffn_g': 1.0 + nrm((DEPTH, D), 0.02),
        'ssd_attn_w_in': nrm((ne, D, D_IN_EVEN), D ** -0.5),
        'ssd_conv_w': nrm((ne, SSD_CONV_W, SSD_CONV_CH), SSD_CONV_W ** -0.5),
        'ssd_conv_b': nrm((ne, SSD_CONV_CH), 0.02),
        'ssd_a_log': jnp.log(unif((ne, 2, SSD_HEADS), 1.0, 16.0)),
        'ssd_dt_bias': dt0 + jnp.log(-jnp.expm1(-dt0)),
        'ssd_d': 1.0 + nrm((ne, SSD_HEADS), 0.02),
        'ssd_norm_g': 1.0 + nrm((ne, D_SSD), 0.02),
        'diff_lambda': nrm((ne, 4, ATT_HALF_DIM), 0.1),
        'diff_norm_g': 1.0 + nrm((ne, ATT_V_DIM), 0.02),
        'ssd_attn_w_out': nrm((ne, D_SSD + D_ATT, D), (D_SSD + D_ATT) ** -0.5),
        'lru_w_in': nrm((no, D, D_IN_ODD), D ** -0.5),
        'lru_conv_w': nrm((no, RNN_CONV_W, D_RNN), RNN_CONV_W ** -0.5),
        'lru_conv_b': nrm((no, D_RNN), 0.02),
        'lru_wa': nrm((no, 2, RNN_BLOCKS, RNN_BLOCK_W, RNN_BLOCK_W), RNN_BLOCK_W ** -0.5),
        'lru_ba': nrm((no, 2, D_RNN), 0.02),
        'lru_wx': nrm((no, 2, RNN_BLOCKS, RNN_BLOCK_W, RNN_BLOCK_W), RNN_BLOCK_W ** -0.5),
        'lru_bx': nrm((no, 2, D_RNN), 0.02),
        'lru_lambda': jnp.log(a_lru) - jnp.log1p(-a_lru),
        'lru_w_out': nrm((no, D_RNN, D), D_RNN ** -0.5),
        'ffn_w_up': nrm((DEPTH, D, 2 * D_FF), D ** -0.5),
        'ffn_conv_w': nrm((DEPTH, FFN_CONV_W, 2 * D_FF), FFN_CONV_W ** -0.5),
        'ffn_conv_b': nrm((DEPTH, 2 * D_FF), 0.02),
        'ffn_w_down': nrm((DEPTH, D_FF, D), D_FF ** -0.5),
        'final_norm_g': 1.0 + nrm((D,), 0.02),
    }


def reference(x_prompt, x_sample, c, cache_attn_k, cache_attn_v, state_ssd_fwd, state_ssd_bwd,
              state_lru_fwd, state_lru_bwd, c_ctx, w_mod, b_mod, norm_mix_g, norm_ffn_g,
              ssd_attn_w_in, ssd_conv_w, ssd_conv_b, ssd_a_log, ssd_dt_bias, ssd_d, ssd_norm_g,
              diff_lambda, diff_norm_g, ssd_attn_w_out, lru_w_in, lru_conv_w, lru_conv_b,
              lru_wa, lru_ba, lru_wx, lru_bx, lru_lambda, lru_w_out, ffn_w_up, ffn_conv_w,
              ffn_conv_b, ffn_w_down, final_norm_g):
    rope = axial_rope_tables(x_sample.shape[1], x_sample.dtype)
    xp, xs = x_prompt, x_sample
    new_k, new_v, new_sf, new_sb, new_lf, new_lb = [], [], [], [], [], []
    for l in range(DEPTH):
        sp_m, sc_m, gp_m, sp_f, sc_f, gp_f = ada_params(c_ctx[None, :], w_mod[l], b_mod[l])
        ss_m, scs_m, gs_m, ss_f, scs_f, gs_f = ada_params(c, w_mod[l], b_mod[l])
        hp = modulate(rmsnorm(xp, norm_mix_g[l]), sp_m, sc_m)
        hs = modulate(rmsnorm(xs, norm_mix_g[l]), ss_m, scs_m)
        j = l // 2
        if l % 2 == 0:
            lam_init = 0.8 - 0.6 * math.exp(-0.3 * l)
            ew = (ssd_attn_w_in[j], ssd_conv_w[j], ssd_conv_b[j], ssd_a_log[j], ssd_dt_bias[j],
                  ssd_d[j], ssd_norm_g[j], diff_lambda[j], diff_norm_g[j], ssd_attn_w_out[j])
            out_p, (kp, vp, sfp, sbp) = even_mixer(hp, *ew, lam_init, None, None)
            out_s, _ = even_mixer(hs, *ew, lam_init, rope,
                                  (cache_attn_k[:, j], cache_attn_v[:, j],
                                   state_ssd_fwd[:, j], state_ssd_bwd[:, j]))
            new_k.append(kp)
            new_v.append(vp)
            new_sf.append(sfp)
            new_sb.append(sbp)
        else:
            ow = (lru_w_in[j], lru_conv_w[j], lru_conv_b[j], lru_wa[j], lru_ba[j], lru_wx[j],
                  lru_bx[j], lru_lambda[j], lru_w_out[j])
            out_p, (lfp, lbp) = odd_mixer(hp, *ow, None)
            out_s, _ = odd_mixer(hs, *ow, (state_lru_fwd[:, j], state_lru_bwd[:, j]))
            new_lf.append(lfp)
            new_lb.append(lbp)
        xp = xp + gp_m * out_p
        xs = xs + gs_m * out_s
        fw = (ffn_w_up[l], ffn_conv_w[l], ffn_conv_b[l], ffn_w_down[l])
        xp = xp + gp_f * conv_ffn(modulate(rmsnorm(xp, norm_ffn_g[l]), sp_f, sc_f), *fw)
        xs = xs + gs_f * conv_ffn(modulate(rmsnorm(xs, norm_ffn_g[l]), ss_f, scs_f), *fw)
    y_prompt = rmsnorm(xp, final_norm_g)
    y_sample = rmsnorm(xs, final_norm_g)
    return (y_prompt, y_sample, jnp.stack(new_k, axis=1), jnp.stack(new_v, axis=1),
            jnp.stack(new_sf, axis=1), jnp.stack(new_sb, axis=1),
            jnp.stack(new_lf, axis=1), jnp.stack(new_lb, axis=1))
```

```cpp
#include <hip/hip_runtime.h>
#include <hip/hip_cooperative_groups.h>
#include <cstdio>
#include <cstdint>
namespace cg = cooperative_groups;
#ifndef EN_G1
#define EN_G1 1
#endif
#ifndef EN_G2
#define EN_G2 1
#endif
#ifndef EN_G3
#define EN_G3 1
#endif
#ifndef REP_SSD
#define REP_SSD 1
#endif
#ifndef REP_ATTN
#define REP_ATTN 1
#endif
#ifndef REP_LRU
#define REP_LRU 1
#endif
#ifndef REP_ELT
#define REP_ELT 1
#endif
#ifndef REP_GP
#define REP_GP 1
#endif
#ifndef REP_P0
#define REP_P0 1
#endif
#ifndef REP_SYNC
#define REP_SYNC 1
#endif
#ifndef FFN_FUSED
#define FFN_FUSED 1
#endif
#ifndef STOP_AT
#define STOP_AT 0
#endif
#ifndef EN_SSD
#define EN_SSD 1
#endif
#ifndef EN_ATTN
#define EN_ATTN 1
#endif
#ifndef EN_LRU
#define EN_LRU 1
#endif
#ifndef EN_GEMM
#define EN_GEMM 1
#endif
#ifndef EN_P0
#define EN_P0 1
#endif
#ifndef EN_ELT
#define EN_ELT 1
#endif

#define LAS __attribute__((address_space(3)))
typedef unsigned short bf16_t;
typedef short bf16x8 __attribute__((ext_vector_type(8)));
typedef float f32x4 __attribute__((ext_vector_type(4)));
typedef float f32x2 __attribute__((ext_vector_type(2)));
typedef unsigned u32x4 __attribute__((ext_vector_type(4)));
typedef unsigned u32x2 __attribute__((ext_vector_type(2)));

constexpr int D = 1024, NTOK = 16384, NPROMPT = 8192;
constexpr int NIN_E = 5632;
constexpr int COL_XBC = 1024, COL_DT = 2304, COL_Q = 2560, COL_K = 3584, COL_V = 4608;
constexpr int NFF2 = 5632, NFF = 2816;
constexpr float EPS = 1e-6f;
constexpr int LDS_BYTES = 147456;
constexpr float QSCALE = 0.125f * 1.4426950408889634f;

constexpr size_t MiB = 1u << 20;
constexpr size_t WS_ROPE = 0;
constexpr size_t WS_BAR = 65536;
constexpr size_t WS_MOD = 1 * MiB;
constexpr size_t WS_LRUW = 2 * MiB;
constexpr size_t WS_DT = 3 * MiB;
constexpr size_t WS_WIN_E = 5 * MiB;
constexpr size_t WS_WOUT_E = 27 * MiB;
constexpr size_t WS_WIN_O = 35 * MiB;
constexpr size_t WS_WOUT_O = 43 * MiB;
constexpr size_t WS_WUP = 47 * MiB;
constexpr size_t WS_WDN = 91 * MiB;
constexpr size_t WS_HBF = 113 * MiB;
constexpr size_t WS_YF = 113 * MiB;
constexpr size_t WS_YB = 145 * MiB;
constexpr size_t WS_P1 = 177 * MiB;
constexpr size_t WS_A2 = 353 * MiB;
constexpr size_t WS_SB = 441 * MiB;
constexpr size_t WS_PART = 443 * MiB;
constexpr size_t WS_END = 445 * MiB;

typedef __bf16 bf16x2_t __attribute__((ext_vector_type(2)));
__device__ __forceinline__ unsigned cvt_pk_bf16(float lo, float hi) { const f32x2 v = {lo, hi}; const bf16x2_t b = __builtin_convertvector(v, bf16x2_t); return __builtin_bit_cast(unsigned, b); }
__device__ __forceinline__ unsigned short f2bf(float f) { return (unsigned short)(cvt_pk_bf16(f, 0.f) & 0xffffu); }
__device__ __forceinline__ float bflo(unsigned u) { return __uint_as_float(u << 16); }
__device__ __forceinline__ float bfhi(unsigned u) { return __uint_as_float(u & 0xffff0000u); }
__device__ __forceinline__ float bf2f(unsigned short h) { return __uint_as_float(((unsigned)h) << 16); }
__device__ __forceinline__ void unpack8(const u32x4 v, float* o) { o[0] = bflo(v.x); o[1] = bfhi(v.x); o[2] = bflo(v.y); o[3] = bfhi(v.y); o[4] = bflo(v.z); o[5] = bfhi(v.z); o[6] = bflo(v.w); o[7] = bfhi(v.w); }
__device__ __forceinline__ u32x4 pack8(const float* v) { u32x4 w; w.x = cvt_pk_bf16(v[0], v[1]); w.y = cvt_pk_bf16(v[2], v[3]); w.z = cvt_pk_bf16(v[4], v[5]); w.w = cvt_pk_bf16(v[6], v[7]); return w; }
__device__ __forceinline__ float shfl_xor_l(float v, int mask, int lane) { return __int_as_float(__builtin_amdgcn_ds_bpermute((lane ^ mask) << 2, __float_as_int(v))); }
__device__ __forceinline__ float shfl_idx_l(float v, int src) { return __int_as_float(__builtin_amdgcn_ds_bpermute(src << 2, __float_as_int(v))); }
__device__ __forceinline__ float x32_sum(float v) { const auto r = __builtin_amdgcn_permlane32_swap(__float_as_uint(v), __float_as_uint(v), false, false); return __uint_as_float(r[0]) + __uint_as_float(r[1]); }
__device__ __forceinline__ float x16_sum(float v) { const auto r = __builtin_amdgcn_permlane16_swap(__float_as_uint(v), __float_as_uint(v), false, false); return __uint_as_float(r[0]) + __uint_as_float(r[1]); }
__device__ __forceinline__ float x32_max(float v) { const auto r = __builtin_amdgcn_permlane32_swap(__float_as_uint(v), __float_as_uint(v), false, false); return fmaxf(__uint_as_float(r[0]), __uint_as_float(r[1])); }
__device__ __forceinline__ float x16_max(float v) { const auto r = __builtin_amdgcn_permlane16_swap(__float_as_uint(v), __float_as_uint(v), false, false); return fmaxf(__uint_as_float(r[0]), __uint_as_float(r[1])); }
#define DPPF(x, ctrl) __int_as_float(__builtin_amdgcn_update_dpp(0, __float_as_int(x), (ctrl), 0xF, 0xF, false))
__device__ __forceinline__ float wave_sum(float v, int) {
    v += DPPF(v, 0xB1); v += DPPF(v, 0x4E); v += DPPF(v, 0x141); v += DPPF(v, 0x140);
    v = x16_sum(v); v = x32_sum(v);
    return v;
}
__device__ __forceinline__ float sigmoidf_(float x) { return 1.f / (1.f + __expf(-x)); }
__device__ __forceinline__ float siluf_(float x) { return x * __builtin_amdgcn_rcpf(1.f + __expf(-x)); }
__device__ __forceinline__ float softplusf_(float x) { return fmaxf(x, 0.f) + __logf(1.f + __expf(-fabsf(x))); }
__device__ __forceinline__ float gelu_tanh(float x) { const float u = 0.7978845608028654f * (x + 0.044715f * x * x * x); return x * __builtin_amdgcn_rcpf(1.f + __expf(-2.f * u)); }
__device__ __forceinline__ int opaque_tid() { int t = threadIdx.x; asm volatile("" : "+v"(t)); return t; }
#define CG_SYNC() for (int rs_ = 0; rs_ < REP_SYNC; ++rs_) do { asm volatile("s_waitcnt vmcnt(0) lgkmcnt(0)" ::: "memory"); grid.sync(); \
    if (__builtin_amdgcn_readfirstlane(threadIdx.x >> 6) == 0) { __builtin_amdgcn_fence(__ATOMIC_ACQUIRE, "agent"); asm volatile("s_waitcnt vmcnt(0)" ::: "memory"); } \
    __syncthreads(); } while (0)
#define GRID_SYNC() for (int rs_ = 0; rs_ < REP_SYNC; ++rs_) { XcdBarrier xb_; xb_.bar = (unsigned*)(WSB + WS_BAR); xb_.x = xb_xcc_id(); xb_.st = (volatile LAS unsigned*)(lds + LDS_BYTES - 16); xcd_barrier(xb_); }
#define LDS_BARRIER() asm volatile("s_waitcnt lgkmcnt(0)\n\ts_barrier" ::: "memory")
#define CBAR() asm volatile("s_waitcnt lgkmcnt(0)" ::: "memory")
#define MFMA16(a, b, c) __builtin_amdgcn_mfma_f32_16x16x32_bf16((a), (b), (c), 0, 0, 0)
__device__ __forceinline__ bf16x8 lds_frag(const LAS unsigned char* p) { return *(const LAS bf16x8*)p; }


#define XB_TMO      128
#define XB_XCNT(j)  (256  + 64 * (j))
#define XB_XSUB(j)  (1280 + 64 * (j))
#define XB_XGEN(j)  (2304 + 64 * (j))
#define XB_TOP      3328
#define XB_TOPGEN   3392
#define XCD_BAR_WORDS 3456
#define XB_SPIN_CAP (1u << 18)
__device__ __forceinline__ unsigned xb_ld(unsigned* p)              { return __hip_atomic_load(p, __ATOMIC_RELAXED, __HIP_MEMORY_SCOPE_AGENT); }
__device__ __forceinline__ unsigned xb_add(unsigned* p, unsigned v) { return __hip_atomic_fetch_add(p, v, __ATOMIC_RELAXED, __HIP_MEMORY_SCOPE_AGENT); }
__device__ __forceinline__ unsigned xb_xcc_id() { return (unsigned)__builtin_amdgcn_s_getreg((3 << 11) | 20) & 0xFu; }
#define XB_SPIN(cond, bar) do { unsigned _sp = 0; while (cond) { __builtin_amdgcn_s_sleep(1); \
    if ((++_sp & 255u) == 0u) { if (xb_ld(&(bar)[XB_TMO])) break; if (_sp > XB_SPIN_CAP) { atomicAdd(&(bar)[XB_TMO], 1u); break; } } } } while (0)
struct XcdBarrier { unsigned* bar; unsigned x; volatile LAS unsigned* st; };
__device__ __forceinline__ XcdBarrier xcd_barrier_post(unsigned* bar, volatile LAS unsigned* st) {
    XcdBarrier b; b.bar = bar; b.x = xb_xcc_id(); b.st = st;
    if (threadIdx.x == 0) (void)xb_add(&bar[XB_XCNT(b.x)], 1u);
    return b;
}
__device__ __forceinline__ void xcd_barrier_complete(unsigned* bar, unsigned x, unsigned& nloc, unsigned& nx) {
    const unsigned G = gridDim.x * gridDim.y * gridDim.z;
    unsigned sum, cnt, mine, sp = 0u;
    for (;;) {
        sum = 0u; cnt = 0u; mine = 0u;
#pragma unroll
        for (unsigned j = 0; j < 16; ++j) { const unsigned c = xb_ld(&bar[XB_XCNT(j)]); sum += c; cnt += (c > 0u) ? 1u : 0u; mine = (j == x) ? c : mine; }
        if (sum == G) break;
        __builtin_amdgcn_s_sleep(1);
        if ((++sp & 255u) == 0u) { if (xb_ld(&bar[XB_TMO])) break; if (sp > XB_SPIN_CAP) { atomicAdd(&bar[XB_TMO], 1u); break; } }
    }
    nloc = mine > 0u ? mine : 1u; nx = cnt > 0u ? cnt : 1u;
}
__device__ __forceinline__ void xcd_barrier(const XcdBarrier& b) {
    asm volatile("s_waitcnt vmcnt(0)" ::: "memory");
    __syncthreads();
    if (threadIdx.x == 0) {
        unsigned* bar = b.bar;
        __builtin_amdgcn_s_waitcnt(0);
        unsigned nloc = b.st[0], nx = b.st[1];
        if (nloc == 0u) { xcd_barrier_complete(bar, b.x, nloc, nx); b.st[0] = nloc; b.st[1] = nx; }
        const unsigned old = xb_add(&bar[XB_XSUB(b.x)], 1u);
        const unsigned gen = old / nloc;
        if (old + 1u == (gen + 1u) * nloc) {
            __builtin_amdgcn_fence(__ATOMIC_RELEASE, "agent");
            asm volatile("s_waitcnt vmcnt(0)" ::: "memory");
            const unsigned og = xb_add(&bar[XB_TOP], 1u);
            const unsigned tg = og / nx;
            if (og + 1u == (tg + 1u) * nx) xb_add(&bar[XB_TOPGEN], 1u);
            else XB_SPIN(xb_ld(&bar[XB_TOPGEN]) == tg, bar);
            __builtin_amdgcn_fence(__ATOMIC_ACQUIRE, "agent");
            xb_add(&bar[XB_XGEN(b.x)], 1u);
            asm volatile("s_waitcnt vmcnt(0)" ::: "memory");
        } else {
            XB_SPIN(xb_ld(&bar[XB_XGEN(b.x)]) == gen, bar);
            __builtin_amdgcn_fence(__ATOMIC_ACQUIRE, "agent");
            asm volatile("s_waitcnt vmcnt(0)" ::: "memory");
        }
    }
    __syncthreads();
}

namespace pg8 {
#define PG8_LAS __attribute__((address_space(3)))
constexpr int BM = 256, BK = 64, HALF = 128, HTB = HALF * BK * 2, STAGE_BYTES = 8 * HTB, NXCD = 8, WGM = 8;
__host__ __device__ __forceinline__ int lds_byte(int r, int c) { const int st = (r >> 4) * 2 + (c >> 5), rr = r & 15, cc = c & 31, ob = rr * 64 + cc * 2; return st * 1024 + (ob ^ (((ob >> 9) & 1) << 5)); }
__host__ __device__ __forceinline__ void stage_rc(int b, int& R, int& C) { const int st = b / 1024, sb = b % 1024, swz = sb ^ (((sb >> 9) & 1) << 5); R = (st >> 1) * 16 + swz / 64; C = (st & 1) * 32 + (swz % 64) / 2; }
__host__ __device__ __forceinline__ int perm32(int rho) { const int n = rho >> 4, i = rho & 15; return 8 * (i >> 2) + 4 * n + (i & 3); }
struct Unit { int pm, pn; };
struct Gemm { const bf16_t* A; const bf16_t* Bt; int M, N, K; };
struct StaticOrder {
    int nM, nN, nwg, G, c;
    __host__ __device__ void init(int M, int N, int G_, int c_) { nM = M / BM; nN = N / BM; nwg = nM * nN; G = G_; c = c_; }
    __host__ __device__ __forceinline__ bool next(int i, Unit& u) const {
        const long L = (long)i * G + c; if (L >= nwg) return false;
        int wgid = (int)L; { const int q = nwg / NXCD, r = nwg % NXCD, xcd = wgid % NXCD, off = wgid / NXCD; wgid = (xcd < r ? xcd * (q + 1) : r * (q + 1) + (xcd - r) * q) + off; }
        const int nig = WGM * nN, gid = wgid / nig, fm = gid * WGM, gsz = (nM - fm) < WGM ? (nM - fm) : WGM;
        u.pm = fm + ((wgid % nig) % gsz); u.pn = (wgid % nig) / gsz; return true;
    }
    __device__ __forceinline__ void a_ready(const Unit&) const {}
    __device__ __forceinline__ void done(const Unit&) const {}
};
template <class Epi, class Sched, bool ALIGN_EPI = false, bool SP2 = false>
__device__ __forceinline__ void gemm_phase(PG8_LAS unsigned char* lds, const Gemm g, const Sched& S, const Epi& E) {
    const int tid = opaque_tid(), wid = __builtin_amdgcn_readfirstlane(tid >> 6), lane = tid & 63, wr = wid >> 2, wc = wid & 3, fr = lane & 15, fq = lane >> 4;
    const int K = g.K, nt = K / BK;
    unsigned voffA[2], voffB[2];
#pragma unroll
    for (int i = 0; i < 2; ++i) { int R, C; stage_rc(tid * 16 + i * 8192, R, C); const int Rb = Epi::PERM ? ((R & ~31) + perm32(R & 31)) : R;
        voffA[i] = (unsigned)(R * K + C) * 2u; voffB[i] = (unsigned)(Rb * K + C) * 2u; }
    const size_t kstep = (size_t)(BK * 2);
    const size_t hstep = (size_t)HALF * K * 2;
    const size_t tstep = 2 * hstep;
    const unsigned ldsw = (unsigned)wid * 1024u;
    const int aoff = lds_byte(wr * 64 + fr, fq * 8), boff = lds_byte(wc * 32 + fr, fq * 8);
#define PG8_SA(b, h) (((b) * 2 + (h)) * HTB)
#define PG8_SB(b, h) ((4 + (b) * 2 + (h)) * HTB)
#define PG8_STAGE(bufoff, gbase, voff) do { _Pragma("unroll") for (int _i = 0; _i < 2; ++_i) \
        __builtin_amdgcn_global_load_lds((const unsigned*)((const char*)(gbase) + (voff)[_i]), (PG8_LAS unsigned*)(lds + (bufoff) + ldsw + _i * 8192), 16, 0, 0); } while (0)
#define PG8_LDA(dst, b, h) do { _Pragma("unroll") for (int m = 0; m < 4; ++m) _Pragma("unroll") for (int k = 0; k < 2; ++k) dst[m][k] = *(const PG8_LAS bf16x8*)(lds + PG8_SA(b, h) + aoff + m * 2048 + k * 1024); } while (0)
#define PG8_LDB(dst, b, h) do { _Pragma("unroll") for (int n = 0; n < 2; ++n) _Pragma("unroll") for (int k = 0; k < 2; ++k) dst[n][k] = *(const PG8_LAS bf16x8*)(lds + PG8_SB(b, h) + boff + n * 2048 + k * 1024); } while (0)
#define PG8_MMA(ai, bj, At, Bt) do { __builtin_amdgcn_s_setprio(1); _Pragma("unroll") for (int m = 0; m < 4; ++m) _Pragma("unroll") for (int n = 0; n < 2; ++n) _Pragma("unroll") for (int k = 0; k < 2; ++k) \
        acc[ai][bj][m][n] = __builtin_amdgcn_mfma_f32_16x16x32_bf16(Bt[n][k], At[m][k], acc[ai][bj][m][n], 0, 0, 0); __builtin_amdgcn_s_setprio(0); } while (0)
#define PG8_WAIT_V(n) asm volatile("s_waitcnt vmcnt(" #n ")" ::: "memory")
#define PG8_WAIT_L(n) asm volatile("s_waitcnt lgkmcnt(" #n ")" ::: "memory")
#define PG8_BAR __builtin_amdgcn_s_barrier()
#define PG8_SCHED __builtin_amdgcn_sched_barrier(0)
    Unit cur, nxt; int ui = 0;
    if (!S.next(0, cur)) return;
    f32x4 acc[2][2][4][2];
#pragma unroll
    for (int a = 0; a < 2; ++a)
#pragma unroll
        for (int b = 0; b < 2; ++b)
#pragma unroll
            for (int m = 0; m < 4; ++m)
#pragma unroll
                for (int n = 0; n < 2; ++n) acc[a][b][m][n] = (f32x4){0.f, 0.f, 0.f, 0.f};
    bf16x8 At[4][2], B0[2][2], B1[2][2];
    const char* cA = (const char*)g.A + (size_t)cur.pm * tstep; const char* cB = (const char*)g.Bt + (size_t)cur.pn * tstep;
    S.a_ready(cur);
    if constexpr (SP2) {
        PG8_STAGE(PG8_SB(0, 0), cB, voffB); PG8_STAGE(PG8_SB(0, 1), cB + hstep, voffB); PG8_STAGE(PG8_SA(0, 0), cA, voffA); PG8_STAGE(PG8_SA(0, 1), cA + hstep, voffA);
        if (wr == 1) PG8_BAR;
        PG8_WAIT_V(2); PG8_BAR;
        PG8_STAGE(PG8_SB(1, 0), cB + kstep, voffB); PG8_STAGE(PG8_SA(1, 0), cA + kstep, voffA); PG8_STAGE(PG8_SB(1, 1), cB + hstep + kstep, voffB);
        PG8_WAIT_V(6); PG8_BAR;
    } else {
        PG8_STAGE(PG8_SB(0, 0), cB, voffB); PG8_STAGE(PG8_SA(0, 0), cA, voffA); PG8_STAGE(PG8_SB(0, 1), cB + hstep, voffB); PG8_STAGE(PG8_SA(0, 1), cA + hstep, voffA);
        if (wr == 1) PG8_BAR;
        PG8_WAIT_V(4); PG8_BAR;
        PG8_STAGE(PG8_SB(1, 0), cB + kstep, voffB); PG8_STAGE(PG8_SA(1, 0), cA + kstep, voffA); PG8_STAGE(PG8_SB(1, 1), cB + hstep + kstep, voffB);
        PG8_WAIT_V(6); PG8_BAR;
    }
    for (;;) {
        const bool has_next = S.next(ui + 1, nxt);
        const char* nA = has_next ? (const char*)g.A + (size_t)nxt.pm * tstep : cA; const char* nB = has_next ? (const char*)g.Bt + (size_t)nxt.pn * tstep : cB;
        for (int t = 0; t < nt; t += 2) {
            const bool last = (t == nt - 2);
            const char* a1 = cA + (size_t)(t + 1) * kstep;
            const char* a2 = last ? nA : cA + (size_t)(t + 2) * kstep; const char* b2 = last ? nB : cB + (size_t)(t + 2) * kstep;
            const char* a3 = a2 + kstep; const char* b3 = b2 + kstep;
            if (last && has_next) S.a_ready(nxt);
            if constexpr (SP2) {
            PG8_LDB(B0, 0, 0); PG8_LDB(B1, 0, 1); PG8_SCHED; PG8_LDA(At, 0, 0); PG8_STAGE(PG8_SA(1, 1), a1 + hstep, voffA);
            PG8_WAIT_V(8); PG8_WAIT_L(0); PG8_BAR; PG8_MMA(0, 0, At, B0); PG8_MMA(0, 1, At, B1); PG8_BAR; PG8_SCHED;
            PG8_LDA(At, 0, 1); PG8_STAGE(PG8_SB(0, 0), b2, voffB); PG8_STAGE(PG8_SB(0, 1), b2 + hstep, voffB); PG8_STAGE(PG8_SA(0, 0), a2, voffA);
            PG8_WAIT_V(8); PG8_WAIT_L(0); PG8_BAR; PG8_MMA(1, 0, At, B0); PG8_MMA(1, 1, At, B1); PG8_BAR; PG8_SCHED;
            PG8_LDB(B0, 1, 0); PG8_LDB(B1, 1, 1); PG8_SCHED; PG8_LDA(At, 1, 0); PG8_STAGE(PG8_SA(0, 1), a2 + hstep, voffA);
            PG8_WAIT_V(8); PG8_WAIT_L(0); PG8_BAR; PG8_MMA(0, 0, At, B0); PG8_MMA(0, 1, At, B1); PG8_BAR; PG8_SCHED;
            PG8_LDA(At, 1, 1); PG8_STAGE(PG8_SB(1, 0), b3, voffB); PG8_STAGE(PG8_SB(1, 1), b3 + hstep, voffB); PG8_STAGE(PG8_SA(1, 0), a3, voffA);
            PG8_WAIT_V(8); PG8_WAIT_L(0); PG8_BAR; PG8_MMA(1, 0, At, B0); PG8_MMA(1, 1, At, B1); PG8_BAR; PG8_SCHED;
            } else {
            PG8_LDB(B0, 0, 0); PG8_SCHED; PG8_LDA(At, 0, 0); PG8_STAGE(PG8_SA(1, 1), a1 + hstep, voffA);
            PG8_WAIT_L(8); PG8_BAR; PG8_WAIT_L(0); PG8_MMA(0, 0, At, B0); PG8_BAR; PG8_SCHED;
            PG8_LDB(B1, 0, 1); PG8_STAGE(PG8_SB(0, 0), b2, voffB);
            PG8_BAR; PG8_WAIT_L(0); PG8_MMA(0, 1, At, B1); PG8_BAR;
            PG8_LDA(At, 0, 1); PG8_STAGE(PG8_SA(0, 0), a2, voffA);
            PG8_BAR; PG8_WAIT_L(0); PG8_MMA(1, 0, At, B0); PG8_BAR; PG8_SCHED;
            PG8_STAGE(PG8_SB(0, 1), b2 + hstep, voffB);
            PG8_WAIT_V(6); PG8_BAR; PG8_MMA(1, 1, At, B1); PG8_BAR;
            PG8_LDB(B0, 1, 0); PG8_SCHED; PG8_LDA(At, 1, 0); PG8_STAGE(PG8_SA(0, 1), a2 + hstep, voffA);
            PG8_WAIT_L(8); PG8_BAR; PG8_WAIT_L(0); PG8_MMA(0, 0, At, B0); PG8_BAR; PG8_SCHED;
            PG8_LDB(B1, 1, 1); PG8_STAGE(PG8_SB(1, 0), b3, voffB);
            PG8_BAR; PG8_WAIT_L(0); PG8_MMA(0, 1, At, B1); PG8_BAR;
            PG8_LDA(At, 1, 1); PG8_STAGE(PG8_SA(1, 0), a3, voffA);
            PG8_BAR; PG8_WAIT_L(0); PG8_MMA(1, 0, At, B0); PG8_BAR; PG8_SCHED;
            PG8_STAGE(PG8_SB(1, 1), b3 + hstep, voffB);
            PG8_WAIT_V(6); PG8_BAR; PG8_MMA(1, 1, At, B1); PG8_BAR;
            }
        }
        if constexpr (ALIGN_EPI) { if (wr == 0) PG8_BAR; }
        E(acc, cur, wr, wc, fr, fq);
        if (!has_next) break;
#pragma unroll
        for (int a = 0; a < 2; ++a)
#pragma unroll
            for (int b = 0; b < 2; ++b)
#pragma unroll
                for (int m = 0; m < 4; ++m)
#pragma unroll
                    for (int n = 0; n < 2; ++n) acc[a][b][m][n] = (f32x4){0.f, 0.f, 0.f, 0.f};
        cur = nxt; cA = nA; cB = nB; ++ui;
        if constexpr (ALIGN_EPI) { if (wr == 1) PG8_BAR; }
    }
    PG8_WAIT_V(0);
    if constexpr (!ALIGN_EPI) { if (wr == 0) PG8_BAR; }
    PG8_BAR;
#undef PG8_SA
#undef PG8_SB
#undef PG8_STAGE
#undef PG8_LDA
#undef PG8_LDB
#undef PG8_MMA
#undef PG8_WAIT_V
#undef PG8_WAIT_L
#undef PG8_BAR
#undef PG8_SCHED
}
}

__device__ __forceinline__ float row_rstd(const float* PART, int row, int fq, int lane) {
    const f32x4 p = *(const f32x4*)(PART + (size_t)row * 16 + 4 * fq); float sacc = (p.x + p.y) + (p.z + p.w);
    sacc = x16_sum(sacc); sacc = x32_sum(sacc);
    return rsqrtf(sacc * (1.f / D) + EPS);
}
struct EpiScaledBf16 {
    static constexpr bool PERM = true, AFTER_DRAIN = false;
    bf16_t* O; int ldc; const float* PART; const float* SB;
    __device__ __forceinline__ void operator()(const f32x4 (&acc)[2][2][4][2], const pg8::Unit& u, int wr, int wc, int fr, int fq) const {
        asm volatile("" : "+v"(fr), "+v"(fq));
        const int row0 = u.pm * 256 + wr * 64 + fr, col0 = u.pn * 256 + wc * 32 + 8 * fq;
        const int cond = u.pm < 32 ? 0 : 1 + ((u.pm - 32) >> 2);
        const float* sp = SB + (size_t)cond * ldc + col0;
        f32x4 sb[2][2];
#pragma unroll
        for (int bj = 0; bj < 2; ++bj) { sb[bj][0] = *(const f32x4*)(sp + bj * 128); sb[bj][1] = *(const f32x4*)(sp + bj * 128 + 4); }
        float rsv[2][4];
#pragma unroll
        for (int ai = 0; ai < 2; ++ai)
#pragma unroll
            for (int m = 0; m < 4; ++m) rsv[ai][m] = row_rstd(PART, row0 + ai * 128 + m * 16, fq, fr + 16 * fq);
#pragma unroll
        for (int ai = 0; ai < 2; ++ai)
#pragma unroll
            for (int m = 0; m < 4; ++m) { const int row = row0 + ai * 128 + m * 16; const float rs = rsv[ai][m];
                bf16_t* rowp = O + (size_t)row * ldc + col0;
#pragma unroll
                for (int bj = 0; bj < 2; ++bj) { const f32x4 v0 = acc[ai][bj][m][0] * rs + sb[bj][0], v1 = acc[ai][bj][m][1] * rs + sb[bj][1];
                    u32x4 w; w.x = cvt_pk_bf16(v0[0], v0[1]); w.y = cvt_pk_bf16(v0[2], v0[3]); w.z = cvt_pk_bf16(v1[0], v1[1]); w.w = cvt_pk_bf16(v1[2], v1[3]);
                    *(u32x4*)(rowp + bj * 128) = w; }
                asm volatile("" ::: "memory"); }
    }
};
struct EpiResid {
    static constexpr bool PERM = true, AFTER_DRAIN = false;
    float* X; const float* gate_base;
    bf16_t* XG; const float* g_next; const float* scale_next; float* PART;
    const float* XinP; const float* XinS;
    __device__ __forceinline__ void operator()(const f32x4 (&acc)[2][2][4][2], const pg8::Unit& u, int wr, int wc, int fr, int fq) const {
        asm volatile("" : "+v"(fr), "+v"(fq));
        const int row0 = u.pm * 256 + wr * 64 + fr, col0 = u.pn * 256 + wc * 32 + 8 * fq;
        const int cond = u.pm < 32 ? 0 : 1 + ((u.pm - 32) >> 2);
        const float* gp = gate_base + (size_t)cond * 6144 + col0;
        const bool nxt = XG != nullptr;
        f32x4 gv[2][2], gs[2][2];
#pragma unroll
        for (int bj = 0; bj < 2; ++bj)
#pragma unroll
            for (int n = 0; n < 2; ++n) { gv[bj][n] = *(const f32x4*)(gp + bj * 128 + n * 4);
                gs[bj][n] = nxt ? *(const f32x4*)(g_next + col0 + bj * 128 + n * 4) * (*(const f32x4*)(scale_next + (size_t)cond * 6144 + col0 + bj * 128 + n * 4) + 1.f) : (f32x4){0.f, 0.f, 0.f, 0.f}; }
        f32x4 xin[2][4];
#define ER_LOAD(slot, gi) do { const float* rp_ = xin_ + (size_t)(row0 + ((gi) >> 2) * 128 + ((gi) & 3) * 16) * 1024 + col0; \
        xin[slot][0] = *(const f32x4*)rp_; xin[slot][1] = *(const f32x4*)(rp_ + 4); xin[slot][2] = *(const f32x4*)(rp_ + 128); xin[slot][3] = *(const f32x4*)(rp_ + 132); } while (0)
        const float* xin_ = u.pm < 32 ? XinP : XinS - (size_t)NPROMPT * 1024;
        ER_LOAD(0, 0);
#pragma unroll
        for (int gi = 0; gi < 8; ++gi) { const int ai = gi >> 2, m = gi & 3, sl = gi & 1;
            if (gi + 1 < 8) ER_LOAD((gi + 1) & 1, gi + 1);
            asm volatile("" ::: "memory");
            const int row = row0 + ai * 128 + m * 16; float* rowp = X + (size_t)row * 1024 + col0; float ss = 0.f;
#pragma unroll
            for (int bj = 0; bj < 2; ++bj) {
                const f32x4 o0 = xin[sl][2 * bj] + gv[bj][0] * acc[ai][bj][m][0], o1 = xin[sl][2 * bj + 1] + gv[bj][1] * acc[ai][bj][m][1];
                *(f32x4*)(rowp + bj * 128) = o0; *(f32x4*)(rowp + bj * 128 + 4) = o1;
                if (nxt) { ss += ((o0.x * o0.x + o0.y * o0.y) + (o0.z * o0.z + o0.w * o0.w)) + ((o1.x * o1.x + o1.y * o1.y) + (o1.z * o1.z + o1.w * o1.w));
                    const f32x4 x0 = o0 * gs[bj][0], x1 = o1 * gs[bj][1];
                    u32x4 w; w.x = cvt_pk_bf16(x0.x, x0.y); w.y = cvt_pk_bf16(x0.z, x0.w); w.z = cvt_pk_bf16(x1.x, x1.y); w.w = cvt_pk_bf16(x1.z, x1.w);
                    *(u32x4*)(XG + (size_t)row * 1024 + col0 + bj * 128) = w; } }
            if (nxt) { ss = x16_sum(ss); ss = x32_sum(ss); if (fq == 0) PART[(size_t)row * 16 + u.pn * 4 + wc] = ss; }
        }
#undef ER_LOAD
    }
};
#define DPPU_ROR1(x) ((unsigned)__builtin_amdgcn_update_dpp(0, (int)(x), 0x121, 0xF, 0xF, false))
#define DPPU_ROL1(x) ((unsigned)__builtin_amdgcn_update_dpp(0, (int)(x), 0x12F, 0xF, 0xF, false))
struct EpiFfnAct {
    static constexpr bool PERM = true, AFTER_DRAIN = false;
    bf16_t* A2; const float* PART; const float* SB; const float* cw; const float* cb; bf16_t* EDGE; LAS unsigned char* xch;
    __device__ __forceinline__ void operator()(f32x4 (&acc)[2][2][4][2], const pg8::Unit& u, int wr, int wc, int, int) const {
        const int t_ = opaque_tid(), fr = t_ & 15, fq = (t_ >> 4) & 3;
        const int row0 = u.pm * 256 + wr * 64 + fr;
        const int cc0 = wc * 32 + 8 * fq, ucol = u.pn * 256 + cc0, chan = u.pn * 128 + cc0;
        const int cond = u.pm < 32 ? 0 : 1 + ((u.pm - 32) >> 2);
        unsigned pu[2][2][4][2][2];
        {
            const float* sp = SB + (size_t)cond * NFF2 + ucol;
            f32x4 sb[2][2];
#pragma unroll
            for (int bj = 0; bj < 2; ++bj) { sb[bj][0] = *(const f32x4*)(sp + bj * 128); sb[bj][1] = *(const f32x4*)(sp + bj * 128 + 4); }
            float rsv[2][4];
#pragma unroll
            for (int ai = 0; ai < 2; ++ai)
#pragma unroll
                for (int m = 0; m < 4; ++m) rsv[ai][m] = row_rstd(PART, row0 + ai * 128 + m * 16, fq, fr + 16 * fq);
#pragma unroll
            for (int ai = 0; ai < 2; ++ai)
#pragma unroll
                for (int m = 0; m < 4; ++m)
#pragma unroll
                    for (int bj = 0; bj < 2; ++bj)
#pragma unroll
                        for (int n = 0; n < 2; ++n) { const f32x4 v = acc[ai][bj][m][n] * rsv[ai][m] + sb[bj][n]; pu[ai][bj][m][n][0] = cvt_pk_bf16(v[0], v[1]); pu[ai][bj][m][n][1] = cvt_pk_bf16(v[2], v[3]); }
        }
        if (u.pm >= 32) {
            bf16_t* eb = EDGE + (size_t)(u.pm - 32) * 4 * NFF2 + ucol;
            if (wr == 0 && fr < 2) {
#pragma unroll
                for (int bj = 0; bj < 2; ++bj)
#pragma unroll
                    for (int n = 0; n < 2; ++n) *(u32x2*)(eb + (size_t)fr * NFF2 + bj * 128 + 4 * n) = (u32x2){pu[0][bj][0][n][0], pu[0][bj][0][n][1]}; }
            if (wr == 1 && fr >= 14) {
#pragma unroll
                for (int bj = 0; bj < 2; ++bj)
#pragma unroll
                    for (int n = 0; n < 2; ++n) *(u32x2*)(eb + (size_t)(fr - 12) * NFF2 + bj * 128 + 4 * n) = (u32x2){pu[1][bj][3][n][0], pu[1][bj][3][n][1]}; }
        }
        LAS u32x2* X2 = (LAS u32x2*)xch; const int wave = wr * 4 + wc;
        if (fr == 0) {
#pragma unroll
            for (int ai = 0; ai < 2; ++ai)
#pragma unroll
                for (int bj = 0; bj < 2; ++bj)
#pragma unroll
                    for (int n = 0; n < 2; ++n) X2[((((wave * 2 + ai) * 2 + 0) * 4 + bj * 2 + n) * 4) + fq] = (u32x2){pu[ai][bj][0][n][0], pu[ai][bj][0][n][1]}; }
        if (fr == 15) {
#pragma unroll
            for (int ai = 0; ai < 2; ++ai)
#pragma unroll
                for (int bj = 0; bj < 2; ++bj)
#pragma unroll
                    for (int n = 0; n < 2; ++n) X2[((((wave * 2 + ai) * 2 + 1) * 4 + bj * 2 + n) * 4) + fq] = (u32x2){pu[ai][bj][3][n][0], pu[ai][bj][3][n][1]}; }
        asm volatile("s_waitcnt lgkmcnt(0)\n\ts_barrier" ::: "memory");
        const LAS unsigned* XU = (const LAS unsigned*)xch;
#pragma unroll
        for (int n = 0; n < 2; ++n) {
#pragma unroll
            for (int ai = 0; ai < 2; ++ai) {
                const bool hasp = !(wr == 0 && ai == 0), hasn = !(wr == 1 && ai == 1);
                const int pw = wr == 1 ? wc : 4 + wc, pa = wr == 1 ? ai : 0;
                const int nw = wr == 0 ? 4 + wc : wc, na = wr == 0 ? ai : 1;
                const int pbase = (((((pw * 2 + pa) * 2 + 1) * 4 + n) * 4) + fq) * 2, nbase = (((((nw * 2 + na) * 2 + 0) * 4 + n) * 4) + fq) * 2;
                unsigned op[4][2];
#pragma unroll
                for (int ep = 0; ep < 2; ++ep) {
                    const int c2 = chan + 4 * n + 2 * ep;
                    const f32x2 wv0 = *(const f32x2*)(cw + c2), wv1 = *(const f32x2*)(cw + NFF2 + c2), wv2 = *(const f32x2*)(cw + 2 * NFF2 + c2), bvv = *(const f32x2*)(cb + c2);
                    const f32x2 wg0 = *(const f32x2*)(cw + NFF + c2), wg1 = *(const f32x2*)(cw + NFF2 + NFF + c2), wg2 = *(const f32x2*)(cw + 2 * NFF2 + NFF + c2), bgv = *(const f32x2*)(cb + NFF + c2);
                    float vc[4][2], gc[4][2];
#pragma unroll
                    for (int bj = 0; bj < 2; ++bj) {
                        const unsigned pe = hasp ? XU[pbase + bj * 16 + ep] : 0u, ne = hasn ? XU[nbase + bj * 16 + ep] : 0u;
                        const f32x2 w0 = bj == 0 ? wv0 : wg0, w1 = bj == 0 ? wv1 : wg1, w2 = bj == 0 ? wv2 : wg2, bb = bj == 0 ? bvv : bgv;
#pragma unroll
                        for (int m = 0; m < 4; ++m) {
                            const unsigned am = pu[ai][bj][m][n][ep];
                            const unsigned rm = DPPU_ROR1(am), lm = DPPU_ROL1(am);
                            const unsigned rp = m > 0 ? DPPU_ROR1(pu[ai][bj][m > 0 ? m - 1 : 0][n][ep]) : pe;
                            const unsigned ln = m < 3 ? DPPU_ROL1(pu[ai][bj][m < 3 ? m + 1 : 3][n][ep]) : ne;
                            const unsigned pm_ = fr == 0 ? rp : rm, qm_ = fr == 15 ? ln : lm;
                            const float r0 = bb.x + w0.x * bflo(pm_) + w1.x * bflo(am) + w2.x * bflo(qm_), r1 = bb.y + w0.y * bfhi(pm_) + w1.y * bfhi(am) + w2.y * bfhi(qm_);
                            if (bj == 0) { vc[m][0] = r0; vc[m][1] = r1; } else { gc[m][0] = r0; gc[m][1] = r1; }
                        }
                    }
#pragma unroll
                    for (int m = 0; m < 4; ++m) op[m][ep] = cvt_pk_bf16(siluf_(gc[m][0]) * vc[m][0], siluf_(gc[m][1]) * vc[m][1]);
                }
#pragma unroll
                for (int m = 0; m < 4; ++m) *(u32x2*)(A2 + (size_t)(row0 + ai * 128 + m * 16) * NFF + chan + 4 * n) = (u32x2){op[m][0], op[m][1]};
                asm volatile("" ::: "memory");
            }
        }
    }
};
__device__ __forceinline__ void ffn_fix_phase(const bf16_t* EDGE, const float* cw, const float* cb, bf16_t* A2) {
    const int gtid = blockIdx.x * 512 + opaque_tid(), nthreads = gridDim.x * 512;
    for (int it = gtid; it < 8 * 3 * 2 * (NFF / 8); it += nthreads) {
        const int cg8 = it % (NFF / 8), r = it / (NFF / 8), which = r & 1, bnd = (r >> 1) % 3, b = r / 6;
        const int c = cg8 * 8, ucol = 256 * (c >> 7) + (c & 127);
        const int tA = b * 4 + bnd, tB = tA + 1;
        const bf16_t* pr = EDGE + ((size_t)tA * 4 + (which == 0 ? 2 : 3)) * NFF2 + ucol;
        const bf16_t* cr = which == 0 ? EDGE + ((size_t)tA * 4 + 3) * NFF2 + ucol : EDGE + ((size_t)tB * 4 + 0) * NFF2 + ucol;
        const bf16_t* nr = EDGE + ((size_t)tB * 4 + (which == 0 ? 0 : 1)) * NFF2 + ucol;
        const int grow = NPROMPT + b * 1024 + (bnd + 1) * 256 - 1 + which;
        float pv[8], pg[8], cv[8], cgv[8], nv[8], ng[8], o[8];
        unpack8(*(const u32x4*)pr, pv); unpack8(*(const u32x4*)(pr + 128), pg); unpack8(*(const u32x4*)cr, cv); unpack8(*(const u32x4*)(cr + 128), cgv);
        unpack8(*(const u32x4*)nr, nv); unpack8(*(const u32x4*)(nr + 128), ng);
#pragma unroll
        for (int e = 0; e < 8; ++e) {
            const float val = cb[c + e] + cw[c + e] * pv[e] + cw[NFF2 + c + e] * cv[e] + cw[2 * NFF2 + c + e] * nv[e];
            const float gg = cb[NFF + c + e] + cw[NFF + c + e] * pg[e] + cw[NFF2 + NFF + c + e] * cgv[e] + cw[2 * NFF2 + NFF + c + e] * ng[e];
            o[e] = siluf_(gg) * val; }
        *(u32x4*)(A2 + (size_t)grow * NFF + c) = pack8(o);
    }
}
__device__ __forceinline__ void ffn_fix_row(const bf16_t* EDGE, const float* cw, const float* cb, bf16_t* A2, int tA, int which, int c) {
    const int ucol = 256 * (c >> 7) + (c & 127), tB = tA + 1;
    const bf16_t* pr = EDGE + ((size_t)tA * 4 + (which == 0 ? 2 : 3)) * NFF2 + ucol;
    const bf16_t* cr = which == 0 ? EDGE + ((size_t)tA * 4 + 3) * NFF2 + ucol : EDGE + ((size_t)tB * 4 + 0) * NFF2 + ucol;
    const bf16_t* nr = EDGE + ((size_t)tB * 4 + (which == 0 ? 0 : 1)) * NFF2 + ucol;
    const int grow = NPROMPT + (tA + 1) * 256 - 1 + which;
    float pv[8], pg[8], cv[8], cgv[8], nv[8], ng[8], o[8];
    unpack8(*(const u32x4*)pr, pv); unpack8(*(const u32x4*)(pr + 128), pg); unpack8(*(const u32x4*)cr, cv); unpack8(*(const u32x4*)(cr + 128), cgv);
    unpack8(*(const u32x4*)nr, nv); unpack8(*(const u32x4*)(nr + 128), ng);
#pragma unroll
    for (int e = 0; e < 8; ++e) {
        const float val = cb[c + e] + cw[c + e] * pv[e] + cw[NFF2 + c + e] * cv[e] + cw[2 * NFF2 + c + e] * nv[e];
        const float gg = cb[NFF + c + e] + cw[NFF + c + e] * pg[e] + cw[NFF2 + NFF + c + e] * cgv[e] + cw[2 * NFF2 + NFF + c + e] * ng[e];
        o[e] = siluf_(gg) * val; }
    *(u32x4*)(A2 + (size_t)grow * NFF + c) = pack8(o);
}
__device__ __forceinline__ void ffn_fix_panel(const bf16_t* EDGE, const float* cw, const float* cb, bf16_t* A2, int pm) {
    if (pm < 32) return;
    const int t = pm - 32, k = t & 3, tid = opaque_tid();
    for (int it = tid; it < 2 * (NFF / 8); it += 512) { const int which = it / (NFF / 8), c = (it % (NFF / 8)) * 8;
        if (which == 1 && k > 0) ffn_fix_row(EDGE, cw, cb, A2, t - 1, 1, c);
        if (which == 0 && k < 3) ffn_fix_row(EDGE, cw, cb, A2, t, 0, c); }
}
struct EpiInEven {
    static constexpr bool PERM = true, AFTER_DRAIN = false;
    bf16_t* P1; float* DT; float* outK; float* outV; const float* rope; int j; const float* PART; const float* SB;
    __device__ __forceinline__ void operator()(const f32x4 (&acc)[2][2][4][2], const pg8::Unit& u, int wr, int wc, int fr, int fq) const {
        asm volatile("" : "+v"(fr), "+v"(fq));
        const int pn = u.pn; const int row0 = u.pm * 256 + wr * 64 + fr, col0 = pn * 256 + wc * 32 + 8 * fq;
        const bool sample = u.pm >= 32;
        const int cond = u.pm < 32 ? 0 : 1 + ((u.pm - 32) >> 2);
        const float* sp = SB + (size_t)cond * NIN_E + col0;
        if (pn == 9) {
            if (wc == 0) { const f32x4 sb0 = *(const f32x4*)sp, sb1 = *(const f32x4*)(sp + 4);
#pragma unroll
                for (int ai = 0; ai < 2; ++ai)
#pragma unroll
                    for (int m = 0; m < 4; ++m) { const int row = row0 + ai * 128 + m * 16; const float rs = row_rstd(PART, row, fq, fr + 16 * fq); float* dp = DT + (size_t)row * 32 + 8 * fq;
                        *(f32x4*)dp = acc[ai][0][m][0] * rs + sb0; *(f32x4*)(dp + 4) = acc[ai][0][m][1] * rs + sb1; }
            }
            return;
        }
        f32x4 sb[2][2];
#pragma unroll
        for (int bj = 0; bj < 2; ++bj) { sb[bj][0] = *(const f32x4*)(sp + bj * 128); sb[bj][1] = *(const f32x4*)(sp + bj * 128 + 4); }
        const bool rope_on = sample && pn >= 10 && pn < 18;
        const bool kv_out = (!sample) && pn >= 14;
        float* ob = nullptr; int ocol = 0;
        if (kv_out) { ob = pn < 18 ? outK : outV; ocol = col0 - (pn < 18 ? COL_K : COL_V); }
#pragma unroll
        for (int ai = 0; ai < 2; ++ai) {
            float rsv[4];
#pragma unroll
            for (int m = 0; m < 4; ++m) rsv[m] = row_rstd(PART, row0 + ai * 128 + m * 16, fq, fr + 16 * fq);
#pragma unroll
            for (int m = 0; m < 4; ++m) {
                const int row = row0 + ai * 128 + m * 16; const float rs = rsv[m];
                f32x4 cs0 = {1.f, 1.f, 1.f, 1.f}, cs1 = cs0, sn0 = {0.f, 0.f, 0.f, 0.f}, sn1 = sn0;
                if (rope_on) { const int t = (row - NPROMPT) & 1023; const int pos = (wc & 1) ? (t & 63) : (t >> 6);
                    const float* rp = rope + pos * 16 + 8 * (fq & 1);
                    cs0 = *(const f32x4*)rp; cs1 = *(const f32x4*)(rp + 4); sn0 = *(const f32x4*)(rp + 1024); sn1 = *(const f32x4*)(rp + 1024 + 4); }
                bf16_t* rowp = P1 + (size_t)row * NIN_E + col0;
#pragma unroll
                for (int bj = 0; bj < 2; ++bj) { f32x4 v0 = acc[ai][bj][m][0] * rs + sb[bj][0], v1 = acc[ai][bj][m][1] * rs + sb[bj][1];
                    if (rope_on) {
                        f32x4 p0, p1;
#pragma unroll
                        for (int e = 0; e < 4; ++e) { p0[e] = shfl_xor_l(v0[e], 32, fr + 16 * fq); p1[e] = shfl_xor_l(v1[e], 32, fr + 16 * fq); }
                        if (fq < 2) { v0 = v0 * cs0 - p0 * sn0; v1 = v1 * cs1 - p1 * sn1; }
                        else        { v0 = p0 * sn0 + v0 * cs0; v1 = p1 * sn1 + v1 * cs1; }
                    }
                    if (pn >= 10 && pn < 14) { v0 = v0 * QSCALE; v1 = v1 * QSCALE; }
                    u32x4 w; w.x = cvt_pk_bf16(v0[0], v0[1]); w.y = cvt_pk_bf16(v0[2], v0[3]); w.z = cvt_pk_bf16(v1[0], v1[1]); w.w = cvt_pk_bf16(v1[2], v1[3]);
                    *(u32x4*)(rowp + bj * 128) = w;
                    if (kv_out) { const int b = row >> 8, t = row & 255; float* op = ob + ((size_t)(b * 2 + j) * 256 + t) * 1024 + ocol + bj * 128;
                        *(f32x4*)op = v0; *(f32x4*)(op + 4) = v1; }
                }
                asm volatile("" ::: "memory");
            }
        }
    }
};

#define GAS __attribute__((address_space(1)))
typedef const GAS float* gcfp;
struct Params {
    gcfp in[38];
    GAS float* out;
    GAS unsigned char* ws;
};

__device__ __forceinline__ void transpose_item(const float* W, int K, int N, bf16_t* WT, int row_shift_from, int row_shift, LAS float* scr, int item, int lane) {
    const int nblk = N / 32, kb = item / nblk, nb = item % nblk, k0 = 64 * kb, n0 = 32 * nb;
    float tv[32];
#pragma unroll
    for (int i = 0; i < 32; ++i) { const int kk = 2 * i + (lane >> 5); tv[i] = W[(size_t)(k0 + kk) * N + n0 + (lane & 31)]; }
#pragma unroll
    for (int i = 0; i < 32; ++i) { const int kk = 2 * i + (lane >> 5); scr[kk * 33 + (lane & 31)] = tv[i]; }
    CBAR();
    const int c = lane & 7;
    const int drow0 = row_shift_from < 0 ? (n0 < NFF ? 256 * (n0 / 128) + (n0 % 128) : 256 * ((n0 - NFF) / 128) + 128 + ((n0 - NFF) % 128)) : n0 + (n0 >= row_shift_from ? row_shift : 0);
#pragma unroll
    for (int jx = 0; jx < 4; ++jx) { const int n = (lane >> 3) + 8 * jx; const LAS float* s = scr + (8 * c) * 33 + n;
        u32x4 o; o.x = cvt_pk_bf16(s[0 * 33], s[1 * 33]); o.y = cvt_pk_bf16(s[2 * 33], s[3 * 33]); o.z = cvt_pk_bf16(s[4 * 33], s[5 * 33]); o.w = cvt_pk_bf16(s[6 * 33], s[7 * 33]);
        *(u32x4*)(WT + (size_t)(drow0 + n) * K + k0 + 8 * c) = o; }
    CBAR();
}

template <int MODE, bool FROM_INPUT>
__device__ __forceinline__ void norm_rows(const float* xp, const float* xs, float* X, const float* g, const float* mod_l, int shift_chunk, bf16_t* hout) {
    const int tid_ = opaque_tid(), lane = tid_ & 63, gw = blockIdx.x * 8 + (tid_ >> 6), NGW = gridDim.x * 8;
    f32x4 gv[4];
#pragma unroll
    for (int jx = 0; jx < 4; ++jx) gv[jx] = *(const f32x4*)(g + 4 * lane + 256 * jx);
    for (int m = gw; m < NTOK; m += NGW) {
        const float* src = FROM_INPUT ? (m < NPROMPT ? xp + (size_t)m * D : xs + (size_t)(m - NPROMPT) * D) : X + (size_t)m * D;
        f32x4 v[4]; float ss = 0.f;
#pragma unroll
        for (int jx = 0; jx < 4; ++jx) { v[jx] = *(const f32x4*)(src + 4 * lane + 256 * jx); ss += (v[jx].x * v[jx].x + v[jx].y * v[jx].y) + (v[jx].z * v[jx].z + v[jx].w * v[jx].w); }
        if (FROM_INPUT) {
#pragma unroll
            for (int jx = 0; jx < 4; ++jx) *(f32x4*)(X + (size_t)m * D + 4 * lane + 256 * jx) = v[jx];
        }
        const float rstd = rsqrtf(wave_sum(ss, lane) * (1.f / D) + EPS);
        if (MODE == 0) {
            const int cond = m < NPROMPT ? 0 : 1 + ((m - NPROMPT) >> 10);
            const float* mp = mod_l + (size_t)cond * 6144 + shift_chunk * 1024;
#pragma unroll
            for (int jx = 0; jx < 4; ++jx) { const f32x4 sh = *(const f32x4*)(mp + 4 * lane + 256 * jx), sc = *(const f32x4*)(mp + 1024 + 4 * lane + 256 * jx);
                const f32x4 y = v[jx] * rstd * gv[jx]; const f32x4 hh = y * (sc + 1.f) + sh;
                u32x2 w; w.x = cvt_pk_bf16(hh.x, hh.y); w.y = cvt_pk_bf16(hh.z, hh.w);
                *(u32x2*)(hout + (size_t)m * D + 4 * lane + 256 * jx) = w; }
        } else {
#pragma unroll
            for (int jx = 0; jx < 4; ++jx) *(f32x4*)(X + (size_t)m * D + 4 * lane + 256 * jx) = v[jx] * rstd * gv[jx];
        }
    }
}

__device__ __forceinline__ void first_rows(const float* xp, const float* xs, float* X, const float* g, const float* mod0, bf16_t* XG, float* PART) {
    const int tid_ = opaque_tid(), lane = tid_ & 63, gw = blockIdx.x * 8 + (tid_ >> 6), NGW = gridDim.x * 8;
    f32x4 gv[4];
#pragma unroll
    for (int jx = 0; jx < 4; ++jx) gv[jx] = *(const f32x4*)(g + 4 * lane + 256 * jx);
    for (int m = gw; m < NTOK; m += NGW) {
        const float* src = m < NPROMPT ? xp + (size_t)m * D : xs + (size_t)(m - NPROMPT) * D;
        f32x4 v[4]; float ss = 0.f;
#pragma unroll
        for (int jx = 0; jx < 4; ++jx) { v[jx] = *(const f32x4*)(src + 4 * lane + 256 * jx); ss += (v[jx].x * v[jx].x + v[jx].y * v[jx].y) + (v[jx].z * v[jx].z + v[jx].w * v[jx].w); }
        ss = wave_sum(ss, lane);
        const int cond = m < NPROMPT ? 0 : 1 + ((m - NPROMPT) >> 10);
        const float* scp = mod0 + (size_t)cond * 6144 + 1024;
#pragma unroll
        for (int jx = 0; jx < 4; ++jx) { const f32x4 sc = *(const f32x4*)(scp + 4 * lane + 256 * jx); const f32x4 xg = v[jx] * gv[jx] * (sc + 1.f);
            u32x2 w; w.x = cvt_pk_bf16(xg.x, xg.y); w.y = cvt_pk_bf16(xg.z, xg.w); *(u32x2*)(XG + (size_t)m * D + 4 * lane + 256 * jx) = w; }
        if (lane < 4) *(f32x4*)(PART + (size_t)m * 16 + 4 * lane) = (f32x4){lane == 0 ? ss : 0.f, 0.f, 0.f, 0.f};
    }
}
__device__ __forceinline__ void sb_gemv_phase(const float* MODp, const bf16_t* WT, int nrows, int lmod, int chunk, float* out, int ostr) {
    const int tid_ = opaque_tid(), lane = tid_ & 63, gw = blockIdx.x * 8 + (tid_ >> 6), NGW = gridDim.x * 8;
    float sh[9][16];
#pragma unroll
    for (int ci = 0; ci < 9; ++ci) { const float* sp = MODp + ((size_t)lmod * 9 + ci) * 6144 + chunk * 1024 + 16 * lane;
#pragma unroll
        for (int q4 = 0; q4 < 4; ++q4) { const f32x4 t = *(const f32x4*)(sp + 4 * q4); sh[ci][4 * q4] = t.x; sh[ci][4 * q4 + 1] = t.y; sh[ci][4 * q4 + 2] = t.z; sh[ci][4 * q4 + 3] = t.w; } }
    for (int n = gw; n < nrows; n += NGW) {
        float w[16]; unpack8(*(const u32x4*)(WT + (size_t)n * 1024 + 16 * lane), w); unpack8(*(const u32x4*)(WT + (size_t)n * 1024 + 16 * lane + 8), w + 8);
        float r[9];
#pragma unroll
        for (int ci = 0; ci < 9; ++ci) { float a = 0.f;
#pragma unroll
            for (int e = 0; e < 16; ++e) a += sh[ci][e] * w[e];
            r[ci] = wave_sum(a, lane); }
        if (lane == 0) {
#pragma unroll
            for (int ci = 0; ci < 9; ++ci) out[(size_t)ci * ostr + n] = r[ci]; }
    }
}

__device__ __forceinline__ void ffn_act_phase(const bf16_t* U, const float* cw, const float* cb, bf16_t* A2) {
    const int gtid = blockIdx.x * 512 + opaque_tid(), nthreads = gridDim.x * 512;
    constexpr int NCG = NFF / 8, RUN = 16, NRUN = NTOK / RUN;
    for (int it = gtid; it < NCG * NRUN; it += nthreads) {
        const int cg8 = it % NCG, run = it / NCG, t0 = run * RUN, col = cg8 * 8;
        const int Lm = t0 < NPROMPT ? 255 : 1023;
        const bool first = (t0 & Lm) == 0, last = ((t0 + RUN) & Lm) == 0;
        float wv[3][8], wg[3][8], bv[8], bg[8];
#pragma unroll
        for (int k = 0; k < 3; ++k) {
#pragma unroll
            for (int e = 0; e < 8; ++e) { wv[k][e] = cw[k * NFF2 + col + e]; wg[k][e] = cw[k * NFF2 + NFF + col + e]; } }
#pragma unroll
        for (int e = 0; e < 8; ++e) { bv[e] = cb[col + e]; bg[e] = cb[NFF + col + e]; }
        float pv[8], pg[8], cv[8], cgv[8], nv[8], ng[8];
        const bf16_t* base = U + (size_t)t0 * NFF2 + 256 * (col >> 7) + (col & 127);
        if (first) {
#pragma unroll
            for (int e = 0; e < 8; ++e) { pv[e] = 0.f; pg[e] = 0.f; } }
        else { unpack8(*(const u32x4*)(base - NFF2), pv); unpack8(*(const u32x4*)(base - NFF2 + 128), pg); }
        unpack8(*(const u32x4*)base, cv); unpack8(*(const u32x4*)(base + 128), cgv);
        for (int i = 0; i < RUN; ++i) {
            if (i == RUN - 1 && last) {
#pragma unroll
                for (int e = 0; e < 8; ++e) { nv[e] = 0.f; ng[e] = 0.f; } }
            else { const bf16_t* nb = base + (size_t)(i + 1) * NFF2; unpack8(*(const u32x4*)nb, nv); unpack8(*(const u32x4*)(nb + 128), ng); }
            float o[8];
#pragma unroll
            for (int e = 0; e < 8; ++e) { const float val = bv[e] + wv[0][e] * pv[e] + wv[1][e] * cv[e] + wv[2][e] * nv[e];
                const float gg = bg[e] + wg[0][e] * pg[e] + wg[1][e] * cgv[e] + wg[2][e] * ng[e]; o[e] = siluf_(gg) * val; }
            *(u32x4*)(A2 + (size_t)(t0 + i) * NFF + col) = pack8(o);
#pragma unroll
            for (int e = 0; e < 8; ++e) { pv[e] = cv[e]; pg[e] = cgv[e]; cv[e] = nv[e]; cgv[e] = ng[e]; }
        }
    }
}

__device__ __forceinline__ void ssd_gate_phase(const bf16_t* YF, const bf16_t* YB, const bf16_t* P1, const float* ng, bf16_t* A2) {
    const int tid_ = opaque_tid(), lane = tid_ & 63, gw = blockIdx.x * 8 + (tid_ >> 6), NGW = gridDim.x * 8;
    for (int m = gw; m < NTOK; m += NGW) {
        float v[2][8]; float ss = 0.f;
#pragma unroll
        for (int jx = 0; jx < 2; ++jx) { const int c = 8 * lane + 512 * jx; float a[8], b[8], z[8];
            unpack8(*(const u32x4*)(YF + (size_t)m * D + c), a); unpack8(*(const u32x4*)(YB + (size_t)m * D + c), b); unpack8(*(const u32x4*)(P1 + (size_t)m * NIN_E + c), z);
#pragma unroll
            for (int e = 0; e < 8; ++e) { const float y = (a[e] + b[e]) * siluf_(z[e]); v[jx][e] = y; ss += y * y; } }
        const float rstd = rsqrtf(wave_sum(ss, lane) * (1.f / D) + EPS);
#pragma unroll
        for (int jx = 0; jx < 2; ++jx) { const int c = 8 * lane + 512 * jx; float o[8];
#pragma unroll
            for (int e = 0; e < 8; ++e) o[e] = v[jx][e] * rstd * ng[c + e];
            *(u32x4*)(A2 + (size_t)m * 2048 + c) = pack8(o); }
    }
}
__device__ __forceinline__ void lru_gate_phase(const bf16_t* YF, const bf16_t* YB, const bf16_t* P1, bf16_t* A2) {
    const int gtid = blockIdx.x * 512 + opaque_tid(), nthreads = gridDim.x * 512;
    for (int it = gtid; it < NTOK * 128; it += nthreads) {
        const int m = it >> 7, c = (it & 127) * 8; float a[8], b[8], gt[8], o[8];
        unpack8(*(const u32x4*)(YF + (size_t)m * D + c), a); unpack8(*(const u32x4*)(YB + (size_t)m * D + c), b); unpack8(*(const u32x4*)(P1 + (size_t)m * 2048 + c), gt);
#pragma unroll
        for (int e = 0; e < 8; ++e) o[e] = (a[e] + b[e]) * gelu_tanh(gt[e]);
        *(u32x4*)(A2 + (size_t)m * D + c) = pack8(o);
    }
}


__device__ __forceinline__ void cache_to_bf16(const float* ck, const float* cv, int j, bf16_t* KC) {
    const int gtid = blockIdx.x * 512 + opaque_tid(), nthreads = gridDim.x * 512;
    for (int it = gtid; it < 2 * 524288; it += nthreads) {
        const int which = it >= 524288, r = it & 524287, b = r >> 16, e8 = r & 65535;
        const float* src = (which ? cv : ck) + ((size_t)(b * 2 + j) * 524288 + (size_t)e8 * 8);
        const f32x4 a = *(const f32x4*)src, c = *(const f32x4*)(src + 4);
        u32x4 w; w.x = cvt_pk_bf16(a.x, a.y); w.y = cvt_pk_bf16(a.z, a.w); w.z = cvt_pk_bf16(c.x, c.y); w.w = cvt_pk_bf16(c.z, c.w);
        *(u32x4*)(KC + (size_t)which * 4194304 + (size_t)b * 524288 + (size_t)e8 * 8) = w;
    }
}

__device__ __forceinline__ void ssd_unit(LAS unsigned char* lds, const bf16_t* P1, const float* DT, int seqrow0, int Lseq, int bidx, bool sample, int h, int j,
                                         const float* conv_w, const float* conv_b, const float* a_log, const float* dt_bias, const float* ssd_d,
                                         const float* st_f, const float* st_b, float* out_f, float* out_b, bf16_t* YF, bf16_t* YB) {
    const int tid = opaque_tid(), wave = __builtin_amdgcn_readfirstlane(tid >> 6), dir = wave >> 2, wq = wave & 3, tg = tid & 255;
    int lane = tid & 63, l15 = lane & 15, lq = lane >> 4;
    LAS unsigned char* base = lds + dir * 65536;
    LAS unsigned char* Cs = base, *Bs = base + 9216, *BTw = base + 18432, *XTs = base + 27648, *Ms = base + 36864;
    const int g = h >> 3;
    const float Aneg = -__expf(a_log[j * 32 + dir * 16 + h]); const float dtb = dt_bias[j * 32 + dir * 16 + h]; const float Dh = ssd_d[j * 16 + h];
    f32x4 Hacc[4];
    {
        const float* st = (dir == 0 ? st_f : st_b) + ((size_t)(bidx * 2 + j) * 16 + h) * 4096;
#pragma unroll
        for (int ni = 0; ni < 4; ++ni)
#pragma unroll
            for (int jj = 0; jj < 4; ++jj) Hacc[ni][jj] = sample ? st[(16 * wq + lq * 4 + jj) * 64 + 16 * ni + l15] : 0.f;
    }
    bf16_t* Y = dir == 0 ? YF : YB;
    const int nch = Lseq >> 6;
    const int a = wq;
    const int cgp = a == 0 ? (lane >> 3) : (lane & 7), run = a == 0 ? (lane & 7) : (lane >> 3);
    const int chan = (a == 0 ? h * 64 : (a == 1 ? 1024 + g * 64 : 1152 + g * 64)) + cgp * 8;
    float dtraw = 0.f;
    u32x4 raw[11];
#define SSD_LOADRAW(ci) do { if (wq < 3) { const int c_ = dir == 0 ? (ci) : nch - 1 - (ci); const int tl0_ = 64 * c_ + 8 * run; \
        _Pragma("unroll") for (int r = 0; r < 11; ++r) { const int tt = tl0_ - 2 + r; \
            raw[r] = (tt >= 0 && tt < Lseq) ? *(const u32x4*)(P1 + (size_t)(seqrow0 + tt) * NIN_E + COL_XBC + chan) : (u32x4){0u, 0u, 0u, 0u}; } } } while (0)
#define SSD_ISSUE(ci) do { const int c_ = dir == 0 ? (ci) : nch - 1 - (ci); const int tb_ = seqrow0 + 64 * c_; \
        if (wq == 0) dtraw = DT[(size_t)(tb_ + lane) * 32 + dir * 16 + h]; } while (0)
#define SSD_PREP(buf) do { LAS unsigned char* Hs_ = base + 46080 + 9216 * (buf); \
        _Pragma("unroll") for (int ni = 0; ni < 4; ++ni) _Pragma("unroll") for (int jj = 0; jj < 4; ++jj) \
            *(LAS unsigned short*)(Hs_ + ((16 * wq + lq * 4 + jj) * 72 + 16 * ni + l15) * 2) = f2bf(Hacc[ni][jj]); \
        if (wq == 0) { const float dtv = softplusf_(dtraw + dtb); const float da = dtv * Aneg; float ps = da; \
            _Pragma("unroll") for (int o = 1; o < 64; o <<= 1) { const float t = shfl_idx_l(ps, lane >= o ? lane - o : lane); if (lane >= o) ps += t; } \
            const float total = shfl_idx_l(ps, 63); \
            ((LAS float*)(base + 64512 + 512 * (buf)))[lane] = dtv; ((LAS float*)(base + 64768 + 512 * (buf)))[lane] = dir == 0 ? ps : (total - ps + da); } } while (0)
    LDS_BARRIER();
    SSD_ISSUE(0);
    SSD_PREP(0);
    SSD_LOADRAW(0);
    for (int i = 0; i < nch; ++i) {
        asm volatile("" : "+v"(lane), "+v"(l15), "+v"(lq));
        const int c = dir == 0 ? i : nch - 1 - i; const int tb = seqrow0 + 64 * c; const int buf = i & 1;
        LAS unsigned char* Hs = base + 46080 + 9216 * buf; LAS float* dts = (LAS float*)(base + 64512 + 512 * buf); LAS float* acss = (LAS float*)(base + 64768 + 512 * buf);
        LDS_BARRIER();
        const float acs_last = acss[dir == 0 ? 63 : 0];
        if (wq < 3) {
            float wv[4][8], bv[8];
            { int chan_ = chan; asm volatile("" : "+v"(chan_));
#pragma unroll
              for (int jj = 0; jj < 4; ++jj) { const float* wp = conv_w + (size_t)(j * 4 + jj) * 1280 + chan_; const f32x4 w0 = *(const f32x4*)wp, w1 = *(const f32x4*)(wp + 4);
                wv[jj][0] = w0.x; wv[jj][1] = w0.y; wv[jj][2] = w0.z; wv[jj][3] = w0.w; wv[jj][4] = w1.x; wv[jj][5] = w1.y; wv[jj][6] = w1.z; wv[jj][7] = w1.w; }
              const f32x4 b0 = *(const f32x4*)(conv_b + j * 1280 + chan_), b1 = *(const f32x4*)(conv_b + j * 1280 + chan_ + 4);
              bv[0] = b0.x; bv[1] = b0.y; bv[2] = b0.z; bv[3] = b0.w; bv[4] = b1.x; bv[5] = b1.y; bv[6] = b1.z; bv[7] = b1.w; }
            unsigned pk[8][4];
            float r0[8], r1[8], r2[8], vp[8];
            unpack8(raw[0], r0); unpack8(raw[1], r1); unpack8(raw[2], r2);
#pragma unroll
            for (int tk = 0; tk < 8; ++tk) {
                float r3[8], v[8];
                unpack8(raw[tk + 3], r3);
#pragma unroll
                for (int e = 0; e < 8; ++e) { const float xx = bv[e] + wv[0][e] * r0[e] + wv[1][e] * r1[e] + wv[2][e] * r2[e] + wv[3][e] * r3[e]; v[e] = xx * __builtin_amdgcn_rcpf(1.f + __expf(-xx)); }
                const int k = 8 * run + tk;
                if (a == 1) { *(LAS u32x4*)(Bs + (k * 72 + cgp * 8) * 2) = pack8(v); const float wk = __expf(acs_last - acss[k]) * dts[k];
#pragma unroll
                    for (int e = 0; e < 8; ++e) v[e] *= wk; }
                else if (a == 2) *(LAS u32x4*)(Cs + (k * 72 + cgp * 8) * 2) = pack8(v);
                if (tk & 1) {
#pragma unroll
                    for (int e = 0; e < 8; ++e) pk[e][tk >> 1] = cvt_pk_bf16(vp[e], v[e]);
                } else {
#pragma unroll
                    for (int e = 0; e < 8; ++e) vp[e] = v[e];
                }
#pragma unroll
                for (int e = 0; e < 8; ++e) { r0[e] = r1[e]; r1[e] = r2[e]; r2[e] = r3[e]; }
                asm volatile("" ::: "memory");
            }
            const int k0r = 8 * run, tpos0 = (k0r & 32) | ((k0r & 8) << 1) | ((k0r & 16) >> 2);
            if (a < 2) { LAS unsigned char* dstT = a == 0 ? XTs : BTw;
#pragma unroll
                for (int e = 0; e < 8; ++e) { *(LAS u32x2*)(dstT + ((cgp * 8 + e) * 72 + tpos0) * 2) = (u32x2){pk[e][0], pk[e][1]}; *(LAS u32x2*)(dstT + ((cgp * 8 + e) * 72 + tpos0 + 8) * 2) = (u32x2){pk[e][2], pk[e][3]}; } }
        }
        if (i + 1 < nch) { SSD_ISSUE(i + 1); SSD_LOADRAW(i + 1); }
        LDS_BARRIER();
        const int q = 16 * wq + l15; const float acs_q = acss[q];
        unsigned mp[4][2];
        {
            bf16x8 cf[2];
#pragma unroll
            for (int kk = 0; kk < 2; ++kk) cf[kk] = lds_frag(Cs + (q * 72 + 32 * kk + lq * 8) * 2);
#pragma unroll
            for (int ni = 0; ni < 4; ++ni) { f32x4 gt = {0.f, 0.f, 0.f, 0.f};
#pragma unroll
                for (int kk = 0; kk < 2; ++kk) gt = MFMA16(lds_frag(Bs + ((16 * ni + l15) * 72 + 32 * kk + lq * 8) * 2), cf[kk], gt);
                float mv[4];
#pragma unroll
                for (int jj = 0; jj < 4; ++jj) { const int k = 16 * ni + 4 * lq + jj; const bool ok = dir == 0 ? (k <= q) : (k >= q);
                    mv[jj] = ok ? gt[jj] * __expf(acs_q - acss[k]) * dts[k] : 0.f; }
                mp[ni][0] = cvt_pk_bf16(mv[0], mv[1]); mp[ni][1] = cvt_pk_bf16(mv[2], mv[3]); }
        }
        {
            bf16x8 mf[2], cf[2];
#pragma unroll
            for (int kk = 0; kk < 2; ++kk) { mf[kk] = __builtin_bit_cast(bf16x8, (u32x4){mp[2 * kk][0], mp[2 * kk][1], mp[2 * kk + 1][0], mp[2 * kk + 1][1]}); cf[kk] = lds_frag(Cs + (q * 72 + 32 * kk + lq * 8) * 2); }
            const float eq = __expf(acs_q); const int qpos = (q & 32) | ((q & 12) << 1) | ((q & 16) >> 2) | (q & 3);
#pragma unroll
            for (int ni = 0; ni < 4; ++ni) { f32x4 yd = {0.f, 0.f, 0.f, 0.f}, yo = yd;
#pragma unroll
                for (int kk = 0; kk < 2; ++kk) { yd = MFMA16(lds_frag(XTs + ((16 * ni + l15) * 72 + 32 * kk + lq * 8) * 2), mf[kk], yd);
                                                 yo = MFMA16(lds_frag(Hs + ((16 * ni + l15) * 72 + 32 * kk + lq * 8) * 2), cf[kk], yo); }
                float yv[4];
#pragma unroll
                for (int jj = 0; jj < 4; ++jj) { yv[jj] = yd[jj] + eq * yo[jj];
                    if (dir == 0) yv[jj] += Dh * bf2f(*(const LAS unsigned short*)(XTs + ((16 * ni + 4 * lq + jj) * 72 + qpos) * 2)); }
                u32x2 w; w.x = cvt_pk_bf16(yv[0], yv[1]); w.y = cvt_pk_bf16(yv[2], yv[3]);
                *(u32x2*)(Y + (size_t)(tb + q) * D + h * 64 + 16 * ni + 4 * lq) = w; }
        }
        {
            const float decay = __expf(acs_last);
            bf16x8 xf[2];
#pragma unroll
            for (int kk = 0; kk < 2; ++kk) xf[kk] = lds_frag(XTs + ((16 * wq + l15) * 72 + 32 * kk + lq * 8) * 2);
#pragma unroll
            for (int ni = 0; ni < 4; ++ni) { Hacc[ni] = Hacc[ni] * decay;
#pragma unroll
                for (int kk = 0; kk < 2; ++kk) Hacc[ni] = MFMA16(xf[kk], lds_frag(BTw + ((16 * ni + l15) * 72 + 32 * kk + lq * 8) * 2), Hacc[ni]); }
        }
        if (i + 1 < nch) SSD_PREP(buf ^ 1);
    }
#undef SSD_LOADRAW
#undef SSD_ISSUE
#undef SSD_PREP
    if (!sample) {
        float* o = (dir == 0 ? out_f : out_b) + ((size_t)(bidx * 2 + j) * 16 + h) * 4096;
#pragma unroll
        for (int ni = 0; ni < 4; ++ni)
#pragma unroll
            for (int jj = 0; jj < 4; ++jj) o[(16 * wq + lq * 4 + jj) * 64 + 16 * ni + l15] = Hacc[ni][jj];
    }
}

__device__ __forceinline__ void lru_unit(LAS unsigned char* lds, const bf16_t* P1, int seqrow0, int Lseq, int bidx, bool sample, int kb, int jo, const bf16_t* LRUW,
                                         const float* conv_w, const float* conv_b, const float* ba, const float* bx, const float* lam,
                                         const float* st_f, const float* st_b, float* out_f, float* out_b, bf16_t* YF, bf16_t* YB) {
    const int tid = opaque_tid(), wave = __builtin_amdgcn_readfirstlane(tid >> 6), lane = tid & 63, dir = wave >> 2, wq = wave & 3, tg = tid & 255, l15 = lane & 15, lq = lane >> 4;
    LAS unsigned char* base = lds + dir * 65536;
    LAS unsigned char* XC = base, *WA = base + 9216, *WX = base + 18432;
    LAS float* As = (LAS float*)(base + 27648); LAS float* Us = (LAS float*)(base + 44288);
    LDS_BARRIER();
#pragma unroll
    for (int which = 0; which < 2; ++which) {
        const bf16_t* src = LRUW + ((size_t)((jo * 2 + dir) * 2 + which) * 16 + kb) * 4096;
        LAS unsigned char* dst = which == 0 ? WA : WX;
#pragma unroll
        for (int it = 0; it < 2; ++it) { const int idx = it * 256 + tg, r = idx >> 3, cc = idx & 7;
            *(LAS u32x4*)(dst + (r * 72 + cc * 8) * 2) = *(const u32x4*)(src + r * 64 + cc * 8); }
    }
    float bav[4], bxv[4], spl[4];
#pragma unroll
    for (int ni = 0; ni < 4; ++ni) { const int ch = kb * 64 + 16 * ni + l15; bav[ni] = ba[(jo * 2 + dir) * 1024 + ch]; bxv[ni] = bx[(jo * 2 + dir) * 1024 + ch]; spl[ni] = -8.f * softplusf_(-lam[(jo * 2 + dir) * 1024 + ch]); }
    float hst = 0.f;
    if (sample && tg < 64) hst = (dir == 0 ? st_f : st_b)[(size_t)(bidx * 2 + jo) * 1024 + kb * 64 + tg];
    bf16_t* Y = dir == 0 ? YF : YB;
    const int ntile = Lseq >> 6;
    u32x4 rawl[2][4];
#define LRU_ISSUE(ti) do { const int c_ = dir == 0 ? (ti) : ntile - 1 - (ti); const int tb_ = seqrow0 + 64 * c_; \
        _Pragma("unroll") for (int it = 0; it < 2; ++it) { const int idx = it * 256 + tg, k = idx >> 3, cgp = idx & 7; const int tl = tb_ + k - seqrow0; \
            _Pragma("unroll") for (int jj = 0; jj < 4; ++jj) { const int tt = tl - 2 + jj; \
                rawl[it][jj] = (tt >= 0 && tt < Lseq) ? *(const u32x4*)(P1 + (size_t)(seqrow0 + tt) * 2048 + 1024 + kb * 64 + cgp * 8) : (u32x4){0u, 0u, 0u, 0u}; } } } while (0)
    LRU_ISSUE(0);
    for (int i = 0; i < ntile; ++i) {
        const int c = dir == 0 ? i : ntile - 1 - i; const int tb = seqrow0 + 64 * c;
        LDS_BARRIER();
#pragma unroll
        for (int it = 0; it < 2; ++it) {
            const int idx = it * 256 + tg, k = idx >> 3, cgp = idx & 7; const int chan = kb * 64 + cgp * 8;
            float av[8];
            { const f32x4 b0 = *(const f32x4*)(conv_b + jo * 1024 + chan), b1 = *(const f32x4*)(conv_b + jo * 1024 + chan + 4);
              av[0] = b0.x; av[1] = b0.y; av[2] = b0.z; av[3] = b0.w; av[4] = b1.x; av[5] = b1.y; av[6] = b1.z; av[7] = b1.w; }
#pragma unroll
            for (int jj = 0; jj < 4; ++jj) { float r[8]; unpack8(rawl[it][jj], r);
                    const float* wp = conv_w + (size_t)(jo * 4 + jj) * 1024 + chan; const f32x4 w0 = *(const f32x4*)wp, w1 = *(const f32x4*)(wp + 4);
                    av[0] += w0.x * r[0]; av[1] += w0.y * r[1]; av[2] += w0.z * r[2]; av[3] += w0.w * r[3]; av[4] += w1.x * r[4]; av[5] += w1.y * r[5]; av[6] += w1.z * r[6]; av[7] += w1.w * r[7]; }
            *(LAS u32x4*)(XC + (k * 72 + cgp * 8) * 2) = pack8(av);
        }
        if (i + 1 < ntile) LRU_ISSUE(i + 1);
        LDS_BARRIER();
        {
            bf16x8 xf[2];
#pragma unroll
            for (int kk = 0; kk < 2; ++kk) xf[kk] = lds_frag(XC + ((16 * wq + l15) * 72 + 32 * kk + lq * 8) * 2);
#pragma unroll
            for (int ni = 0; ni < 4; ++ni) { f32x4 ra = {0.f, 0.f, 0.f, 0.f}, ri = ra;
#pragma unroll
                for (int kk = 0; kk < 2; ++kk) { ra = MFMA16(xf[kk], lds_frag(WA + ((16 * ni + l15) * 72 + 32 * kk + lq * 8) * 2), ra);
                                                 ri = MFMA16(xf[kk], lds_frag(WX + ((16 * ni + l15) * 72 + 32 * kk + lq * 8) * 2), ri); }
#pragma unroll
                for (int jj = 0; jj < 4; ++jj) { const int tok = 16 * wq + 4 * lq + jj, ch = 16 * ni + l15;
                    const float r = __builtin_amdgcn_rcpf(1.f + __expf(-(ra[jj] + bav[ni]))), ig = __builtin_amdgcn_rcpf(1.f + __expf(-(ri[jj] + bxv[ni])));
                    const float log_a = spl[ni] * r; const float a = __expf(log_a);
                    const float xc = bf2f(*(const LAS unsigned short*)(XC + (tok * 72 + ch) * 2));
                    const float uu = __builtin_amdgcn_sqrtf(fmaxf(1.f - a * a, 0.f)) * (ig * xc);
                    As[tok * 65 + ch] = a; Us[tok * 65 + ch] = uu; }
            }
        }
        LDS_BARRIER();
        if (tg < 64) {
#pragma unroll 8
            for (int s = 0; s < 64; ++s) { const int tok = dir == 0 ? s : 63 - s;
                hst = As[tok * 65 + tg] * hst + Us[tok * 65 + tg];
                Us[tok * 65 + tg] = hst; }
        }
        LDS_BARRIER();
#pragma unroll
        for (int it = 0; it < 2; ++it) { const int idx = it * 256 + tg, tok = idx >> 3, c8 = idx & 7; float o[8];
#pragma unroll
            for (int e = 0; e < 8; ++e) o[e] = Us[tok * 65 + c8 * 8 + e];
            *(u32x4*)(Y + (size_t)(tb + tok) * D + kb * 64 + c8 * 8) = pack8(o); }
    }
#undef LRU_ISSUE
    if (!sample && tg < 64) (dir == 0 ? out_f : out_b)[(size_t)(bidx * 2 + jo) * 1024 + kb * 64 + tg] = hst;
}

__device__ __forceinline__ void attn_unit(LAS unsigned char* lds, const bf16_t* P1, const bf16_t* cacheK, const bf16_t* cacheV, int seqrow0, int nkc, int nkn, int qrow, int h,
                                          const float* lp, float lam_init, const float* sub_g, bf16_t* A2) {
    const int tid = opaque_tid(), wave = __builtin_amdgcn_readfirstlane(tid >> 6), lane = tid & 63, comp = wave >> 2, wq = wave & 3, l15 = lane & 15, lq = lane >> 4;
    LAS unsigned char* Ks = lds; LAS unsigned char* VT = lds + 17408; LAS unsigned char* Pw = lds + 35840 + wave * 4608; LAS float* O1 = (LAS float*)(lds + 73728);
    bf16x8 qf[2][2];
    {
        const bf16_t* qb = P1 + (size_t)(qrow + 32 * wq) * NIN_E + COL_Q + h * 128 + comp * 64;
#pragma unroll
        for (int mi = 0; mi < 2; ++mi)
#pragma unroll
            for (int kk = 0; kk < 2; ++kk) qf[mi][kk] = *(const bf16x8*)(qb + (size_t)(16 * mi + l15) * NIN_E + 32 * kk + lq * 8);
    }
    float m_run[2] = {-1e30f, -1e30f}, l_run[2] = {0.f, 0.f};
    f32x4 oT[2][8];
#pragma unroll
    for (int mi = 0; mi < 2; ++mi)
#pragma unroll
        for (int ei = 0; ei < 8; ++ei) oT[mi][ei] = (f32x4){0.f, 0.f, 0.f, 0.f};
    const int ntile = (nkc + nkn) >> 6;
    const int sk = tid >> 3, sc0 = (tid & 7) * 16;
    const int vkey = tid & 63, vc0 = (tid >> 6) * 16, vpos = (vkey & 32) | ((vkey & 12) << 1) | ((vkey & 16) >> 2) | (vkey & 3);
    u32x4 pk0, pk1, pv0, pv1;
#define ATT_PREFETCH(T) do { const int key0_ = (T) * 64; \
        const bf16_t* kp_ = key0_ < nkc ? cacheK + (size_t)(key0_ + sk) * 1024 + h * 128 + sc0 : P1 + (size_t)(seqrow0 + key0_ - nkc + sk) * NIN_E + COL_K + h * 128 + sc0; \
        const bf16_t* vp_ = key0_ < nkc ? cacheV + (size_t)(key0_ + vkey) * 1024 + h * 128 + vc0 : P1 + (size_t)(seqrow0 + key0_ - nkc + vkey) * NIN_E + COL_V + h * 128 + vc0; \
        pk0 = *(const u32x4*)kp_; pk1 = *(const u32x4*)(kp_ + 8); pv0 = *(const u32x4*)vp_; pv1 = *(const u32x4*)(vp_ + 8); } while (0)
    ATT_PREFETCH(0);
    for (int tile = 0; tile < ntile; ++tile) {
        LDS_BARRIER();
        {
            *(LAS u32x4*)(Ks + (sk * 136 + sc0) * 2) = pk0; *(LAS u32x4*)(Ks + (sk * 136 + sc0 + 8) * 2) = pk1;
            const unsigned vw[8] = {pv0.x, pv0.y, pv0.z, pv0.w, pv1.x, pv1.y, pv1.z, pv1.w};
#pragma unroll
            for (int e = 0; e < 8; ++e) { *(LAS unsigned short*)(VT + ((vc0 + 2 * e) * 72 + vpos) * 2) = (unsigned short)(vw[e] & 0xffffu); *(LAS unsigned short*)(VT + ((vc0 + 2 * e + 1) * 72 + vpos) * 2) = (unsigned short)(vw[e] >> 16); }
        }
        LDS_BARRIER();
        if (tile + 1 < ntile) ATT_PREFETCH(tile + 1);
        f32x4 st[2][4];
#pragma unroll
        for (int ni = 0; ni < 4; ++ni) {
            bf16x8 kf[2];
#pragma unroll
            for (int kk = 0; kk < 2; ++kk) kf[kk] = lds_frag(Ks + ((16 * ni + l15) * 136 + comp * 64 + 32 * kk + lq * 8) * 2);
#pragma unroll
            for (int mi = 0; mi < 2; ++mi) { f32x4 s = {0.f, 0.f, 0.f, 0.f};
#pragma unroll
                for (int kk = 0; kk < 2; ++kk) s = MFMA16(kf[kk], qf[mi][kk], s);
                st[mi][ni] = s; }
        }
        float mnew[2]; bool changed = false;
#pragma unroll
        for (int mi = 0; mi < 2; ++mi) {
            float mx = -1e30f;
#pragma unroll
            for (int ni = 0; ni < 4; ++ni)
#pragma unroll
                for (int jj = 0; jj < 4; ++jj) mx = fmaxf(mx, st[mi][ni][jj]);
            mx = x16_max(mx); mx = x32_max(mx);
            mnew[mi] = mx > m_run[mi] + 8.f ? mx : m_run[mi];
            changed = changed || (mnew[mi] != m_run[mi]);
        }
        if (__builtin_amdgcn_ballot_w64(changed) != 0ull) {
#pragma unroll
            for (int mi = 0; mi < 2; ++mi) { const float alpha = __builtin_amdgcn_exp2f(m_run[mi] - mnew[mi]); m_run[mi] = mnew[mi]; l_run[mi] *= alpha;
#pragma unroll
                for (int ei = 0; ei < 8; ++ei) oT[mi][ei] = oT[mi][ei] * alpha; }
        }
        unsigned pp[2][4][2];
#pragma unroll
        for (int mi = 0; mi < 2; ++mi) {
            float ls = 0.f;
#pragma unroll
            for (int ni = 0; ni < 4; ++ni) { float pv[4];
#pragma unroll
                for (int jj = 0; jj < 4; ++jj) { pv[jj] = __builtin_amdgcn_exp2f(st[mi][ni][jj] - m_run[mi]); ls += pv[jj]; }
                pp[mi][ni][0] = cvt_pk_bf16(pv[0], pv[1]); pp[mi][ni][1] = cvt_pk_bf16(pv[2], pv[3]); }
            l_run[mi] += ls;
        }
#pragma unroll
        for (int kk = 0; kk < 2; ++kk) {
            bf16x8 pa[2];
#pragma unroll
            for (int mi = 0; mi < 2; ++mi) pa[mi] = __builtin_bit_cast(bf16x8, (u32x4){pp[mi][2 * kk][0], pp[mi][2 * kk][1], pp[mi][2 * kk + 1][0], pp[mi][2 * kk + 1][1]});
#pragma unroll
            for (int ei = 0; ei < 8; ++ei) { const bf16x8 vb = lds_frag(VT + ((16 * ei + l15) * 72 + 32 * kk + lq * 8) * 2);
#pragma unroll
                for (int mi = 0; mi < 2; ++mi) oT[mi][ei] = MFMA16(vb, pa[mi], oT[mi][ei]); }
        }
        CBAR();
    }
#pragma unroll
    for (int mi = 0; mi < 2; ++mi) { float l = l_run[mi]; l = x16_sum(l); l = x32_sum(l); const float inv = 1.f / l;
#pragma unroll
        for (int ei = 0; ei < 8; ++ei) oT[mi][ei] = oT[mi][ei] * inv; }
#undef ATT_PREFETCH
    const float lam = __expf(wave_sum(lp[lane] * lp[64 + lane], lane)) - __expf(wave_sum(lp[128 + lane] * lp[192 + lane], lane)) + lam_init;
    const float oscale = 1.f - lam_init;
    if (comp == 1) {
#pragma unroll
        for (int mi = 0; mi < 2; ++mi)
#pragma unroll
            for (int ei = 0; ei < 8; ++ei) *(LAS f32x4*)(O1 + (32 * wq + 16 * mi + l15) * 132 + 16 * ei + 4 * lq) = oT[mi][ei];
    }
    __syncthreads();
    if (comp == 0) {
#pragma unroll
        for (int mi = 0; mi < 2; ++mi) { float ss = 0.f;
#pragma unroll
            for (int ei = 0; ei < 8; ++ei) { const f32x4 o1 = *(const LAS f32x4*)(O1 + (32 * wq + 16 * mi + l15) * 132 + 16 * ei + 4 * lq); const f32x4 o = oT[mi][ei] - o1 * lam; oT[mi][ei] = o;
                ss += (o.x * o.x + o.y * o.y) + (o.z * o.z + o.w * o.w); }
            ss = x16_sum(ss); ss = x32_sum(ss);
            const float rstd = rsqrtf(ss * (1.f / 128.f) + EPS) * oscale;
            bf16_t* op = A2 + (size_t)(qrow + 32 * wq + 16 * mi + l15) * 2048 + 1024 + h * 128 + 4 * lq;
#pragma unroll
            for (int ei = 0; ei < 8; ++ei) { const f32x4 gsub = *(const f32x4*)(sub_g + 16 * ei + 4 * lq); const f32x4 o = oT[mi][ei] * rstd * gsub;
                u32x2 w; w.x = cvt_pk_bf16(o.x, o.y); w.y = cvt_pk_bf16(o.z, o.w); *(u32x2*)(op + 16 * ei) = w; }
        }
    }
}

__device__ __forceinline__ int opaque_idx(int i) { asm volatile("" : "+s"(i)); return i; }
__device__ __forceinline__ GAS unsigned char* opaque_ptr(GAS unsigned char* q) { asm volatile("" : "+s"(q)); return q; }
#define x_prompt ((const float*)p.in[opaque_idx(0)])
#define x_sample ((const float*)p.in[opaque_idx(1)])
#define cvec ((const float*)p.in[opaque_idx(2)])
#define cache_k ((const float*)p.in[opaque_idx(3)])
#define cache_v ((const float*)p.in[opaque_idx(4)])
#define st_ssd_f ((const float*)p.in[opaque_idx(5)])
#define st_ssd_b ((const float*)p.in[opaque_idx(6)])
#define st_lru_f ((const float*)p.in[opaque_idx(7)])
#define st_lru_b ((const float*)p.in[opaque_idx(8)])
#define c_ctx ((const float*)p.in[opaque_idx(9)])
#define w_mod ((const float*)p.in[opaque_idx(10)])
#define b_mod ((const float*)p.in[opaque_idx(11)])
#define norm_mix_g ((const float*)p.in[opaque_idx(12)])
#define norm_ffn_g ((const float*)p.in[opaque_idx(13)])
#define w_in_e ((const float*)p.in[opaque_idx(14)])
#define ssd_conv_w ((const float*)p.in[opaque_idx(15)])
#define ssd_conv_b ((const float*)p.in[opaque_idx(16)])
#define ssd_a_log ((const float*)p.in[opaque_idx(17)])
#define ssd_dt_bias ((const float*)p.in[opaque_idx(18)])
#define ssd_d ((const float*)p.in[opaque_idx(19)])
#define ssd_norm_g ((const float*)p.in[opaque_idx(20)])
#define diff_lambda ((const float*)p.in[opaque_idx(21)])
#define diff_norm_g ((const float*)p.in[opaque_idx(22)])
#define w_out_e ((const float*)p.in[opaque_idx(23)])
#define lru_w_in ((const float*)p.in[opaque_idx(24)])
#define lru_conv_w ((const float*)p.in[opaque_idx(25)])
#define lru_conv_b ((const float*)p.in[opaque_idx(26)])
#define lru_wa ((const float*)p.in[opaque_idx(27)])
#define lru_ba ((const float*)p.in[opaque_idx(28)])
#define lru_wx ((const float*)p.in[opaque_idx(29)])
#define lru_bx ((const float*)p.in[opaque_idx(30)])
#define lru_lambda ((const float*)p.in[opaque_idx(31)])
#define lru_w_out ((const float*)p.in[opaque_idx(32)])
#define ffn_w_up ((const float*)p.in[opaque_idx(33)])
#define ffn_conv_w ((const float*)p.in[opaque_idx(34)])
#define ffn_conv_b ((const float*)p.in[opaque_idx(35)])
#define ffn_w_down ((const float*)p.in[opaque_idx(36)])
#define final_norm_g ((const float*)p.in[opaque_idx(37)])
#define WSB ((unsigned char*)opaque_ptr(p.ws))
#define OUTB ((float*)opaque_ptr((GAS unsigned char*)p.out))
#define X OUTB
#define outK (OUTB + 16777216)
#define outV (OUTB + 2 * 16777216)
#define outSF (OUTB + 3 * 16777216)
#define outSB (OUTB + 3 * 16777216 + 4194304)
#define outLF (OUTB + 3 * 16777216 + 2 * 4194304)
#define outLB (OUTB + 3 * 16777216 + 2 * 4194304 + 65536)
#define ROPE ((float*)(WSB + WS_ROPE))
#define MOD ((float*)(WSB + WS_MOD))
#define LRUW ((bf16_t*)(WSB + WS_LRUW))
#define DTB ((float*)(WSB + WS_DT))
#define WIN_E ((bf16_t*)(WSB + WS_WIN_E))
#define WOUT_E ((bf16_t*)(WSB + WS_WOUT_E))
#define WIN_O ((bf16_t*)(WSB + WS_WIN_O))
#define WOUT_O ((bf16_t*)(WSB + WS_WOUT_O))
#define WUP ((bf16_t*)(WSB + WS_WUP))
#define WDN ((bf16_t*)(WSB + WS_WDN))
#define HBF ((bf16_t*)(WSB + WS_HBF))
#define YF ((bf16_t*)(WSB + WS_YF))
#define YB ((bf16_t*)(WSB + WS_YB))
#define P1 ((bf16_t*)(WSB + WS_P1))
#define A2 ((bf16_t*)(WSB + WS_A2))
#define SBB ((float*)(WSB + WS_SB))
#define PARTB ((float*)(WSB + WS_PART))
#define KCB ((bf16_t*)(WSB + WS_A2 + 64 * MiB))
__global__ void __launch_bounds__(512, 2) mega_fwd(Params p) {
    extern __shared__ __attribute__((aligned(16))) unsigned char lds_raw[];
    LAS unsigned char* lds = (LAS unsigned char*)lds_raw;
    cg::grid_group grid = cg::this_grid();
    { volatile LAS unsigned* st_ = (volatile LAS unsigned*)(lds + LDS_BYTES - 16); if (threadIdx.x < 2) st_[threadIdx.x] = 0u; }
    __syncthreads();
    (void)xcd_barrier_post((unsigned*)((unsigned char*)p.ws + WS_BAR), (volatile LAS unsigned*)(lds + LDS_BYTES - 16));
    const int G = gridDim.x, bx = blockIdx.x;
    const int vbx = (G % 8 == 0) ? (bx % 8) * (G / 8) + bx / 8 : bx;
    for (int rep = 0; rep < REP_P0; ++rep) {
        __syncthreads();
        const int tid = opaque_tid(), lane = tid & 63, wave = __builtin_amdgcn_readfirstlane(tid >> 6);
        const int gw = bx * 8 + wave, NGW = G * 8, gtid = bx * 512 + tid, nthreads = G * 512;
        LAS float* scr = (LAS float*)(lds + wave * 16384);
        constexpr int I_WIN_E = 16 * 169, I_WOUT_E = 32 * 32, I_WIN_O = 16 * 64, I_WOUT_O = 16 * 32, I_WUP = 16 * 176, I_WDN = 44 * 32;
        constexpr int NITEMS = 2 * I_WIN_E + 2 * I_WOUT_E + 2 * I_WIN_O + 2 * I_WOUT_O + 4 * I_WUP + 4 * I_WDN;
        for (int it = gw; it < NITEMS; it += NGW) {
            int r = it;
            if (r < 2 * I_WIN_E) { const int j = r / I_WIN_E; transpose_item(w_in_e + (size_t)j * 1024 * 5408, 1024, 5408, WIN_E + (size_t)j * NIN_E * 1024, 2336, 224, scr, r % I_WIN_E, lane); continue; } r -= 2 * I_WIN_E;
            if (r < 2 * I_WOUT_E) { const int j = r / I_WOUT_E; transpose_item(w_out_e + (size_t)j * 2048 * 1024, 2048, 1024, WOUT_E + (size_t)j * 1024 * 2048, 1 << 30, 0, scr, r % I_WOUT_E, lane); continue; } r -= 2 * I_WOUT_E;
            if (r < 2 * I_WIN_O) { const int j = r / I_WIN_O; transpose_item(lru_w_in + (size_t)j * 1024 * 2048, 1024, 2048, WIN_O + (size_t)j * 2048 * 1024, 1 << 30, 0, scr, r % I_WIN_O, lane); continue; } r -= 2 * I_WIN_O;
            if (r < 2 * I_WOUT_O) { const int j = r / I_WOUT_O; transpose_item(lru_w_out + (size_t)j * 1024 * 1024, 1024, 1024, WOUT_O + (size_t)j * 1024 * 1024, 1 << 30, 0, scr, r % I_WOUT_O, lane); continue; } r -= 2 * I_WOUT_O;
            if (r < 4 * I_WUP) { const int l = r / I_WUP; transpose_item(ffn_w_up + (size_t)l * 1024 * 5632, 1024, 5632, WUP + (size_t)l * 5632 * 1024, -1, 0, scr, r % I_WUP, lane); continue; } r -= 4 * I_WUP;
            { const int l = r / I_WDN; transpose_item(ffn_w_down + (size_t)l * 2816 * 1024, 2816, 1024, WDN + (size_t)l * 1024 * 2816, 1 << 30, 0, scr, r % I_WDN, lane); }
        }
        for (int i = gtid; i < 2 * 224 * 128; i += nthreads) { const int j = i / (224 * 128), r = (i / 128) % 224, cc = i % 128;
            *(u32x4*)(WIN_E + ((size_t)j * NIN_E + 2336 + r) * 1024 + cc * 8) = (u32x4){0u, 0u, 0u, 0u}; }
        for (int i = gtid; i < 524288; i += nthreads) { const int k = i & 63, jj = (i >> 6) & 63, blk = (i >> 12) & 15, which = (i >> 16) & 1, ld = i >> 17;
            const float* src = which == 0 ? lru_wa : lru_wx; LRUW[i] = f2bf(src[((size_t)ld * 16 + blk) * 4096 + k * 64 + jj]); }
        if (bx == 0) { for (int i = tid; i < 1024; i += 512) { const int pos = i >> 4, fi = i & 15; const float fr = powf(10000.f, -(float)(2 * fi) / 32.f); const float ang = (float)pos * fr;
            ROPE[i] = cosf(ang); ROPE[1024 + i] = sinf(ang); } }
        __syncthreads();
        LAS float* sv = (LAS float*)lds;
        LAS float* red = (LAS float*)(lds + 36864);
        bool sv_ready = false;
        for (int unit = bx; unit < 4 * 96; unit += G) {
            if (!sv_ready) { for (int i = tid; i < 9 * 1024; i += 512) { const int ci = i >> 10, k = i & 1023; const float cvv = ci == 0 ? c_ctx[k] : cvec[(ci - 1) * 1024 + k]; sv[i] = siluf_(cvv); } sv_ready = true; }
            __syncthreads();
            const int l = unit / 96, nb = unit % 96, col = nb * 64 + lane;
            float acc9[9];
#pragma unroll
            for (int ci = 0; ci < 9; ++ci) acc9[ci] = 0.f;
            const float* wp = w_mod + ((size_t)l * 1024 + wave * 128) * 6144 + col;
#pragma unroll 4
            for (int k4 = 0; k4 < 32; ++k4) {
                const float w0 = wp[(size_t)(4 * k4) * 6144], w1 = wp[(size_t)(4 * k4 + 1) * 6144], w2 = wp[(size_t)(4 * k4 + 2) * 6144], w3 = wp[(size_t)(4 * k4 + 3) * 6144];
#pragma unroll
                for (int ci = 0; ci < 9; ++ci) { const f32x4 s4 = *(const LAS f32x4*)(sv + ci * 1024 + wave * 128 + 4 * k4); acc9[ci] += (s4.x * w0 + s4.y * w1) + (s4.z * w2 + s4.w * w3); }
            }
#pragma unroll
            for (int ci = 0; ci < 9; ++ci) red[(wave * 9 + ci) * 64 + lane] = acc9[ci];
            __syncthreads();
            for (int e = tid; e < 576; e += 512) { const int ci = e >> 6, ln = e & 63; float s = 0.f;
#pragma unroll
                for (int w = 0; w < 8; ++w) s += red[(w * 9 + ci) * 64 + ln];
                MOD[((size_t)l * 9 + ci) * 6144 + nb * 64 + ln] = s + b_mod[l * 6144 + nb * 64 + ln]; }
        }
    }
    CG_SYNC();
    first_rows(x_prompt, x_sample, X, norm_mix_g, MOD, HBF, PARTB);
    cache_to_bf16(cache_k, cache_v, 0, KCB);
    for (int jj = 0; jj < 2; ++jj) { sb_gemv_phase(MOD, WIN_E + (size_t)jj * NIN_E * 1024, NIN_E, 2 * jj, 0, SBB + (size_t)jj * 9 * NIN_E, NIN_E);
                                     sb_gemv_phase(MOD, WIN_O + (size_t)jj * 2048 * 1024, 2048, 2 * jj + 1, 0, SBB + 101376 + (size_t)jj * 18432, 2048); }
    for (int ll = 0; ll < 4; ++ll) sb_gemv_phase(MOD, WUP + (size_t)ll * NFF2 * 1024, NFF2, ll, 3, SBB + 138240 + (size_t)ll * 50688, NFF2);
    GRID_SYNC();

    for (int l = 0; l < 4; ++l) {
        const int j = l >> 1;
#define mod_l (MOD + (size_t)l * 9 * 6144)
        if ((l & 1) == 0) {
            {
                pg8::Gemm g{HBF, WIN_E + (size_t)j * NIN_E * 1024, NTOK, NIN_E, 1024}; pg8::StaticOrder S; S.init(NTOK, NIN_E, G, bx);
                if (l == 2) cache_to_bf16(cache_k, cache_v, 1, KCB);
                EpiInEven E{P1, DTB, outK, outV, ROPE, j, PARTB, SBB + (size_t)j * 9 * NIN_E};
                for (int rep = 0; rep < REP_GP; ++rep) pg8::gemm_phase<EpiInEven, pg8::StaticOrder, true, true>(lds, g, S, E);
            }
            GRID_SYNC();
            if (STOP_AT == 1) return;
            {
                for (int rep = 0; rep < REP_SSD; ++rep)
                for (int bun = vbx; bun < 256; bun += G) {
                    if (!EN_SSD) break;
                    if (bun < 128) { const int b = bun >> 4, h = bun & 15;
                        ssd_unit(lds, P1, DTB, NPROMPT + b * 1024, 1024, b, true, h, j, ssd_conv_w, ssd_conv_b, ssd_a_log, ssd_dt_bias, ssd_d, st_ssd_f, st_ssd_b, outSF, outSB, YF, YB);
                    } else { for (int q4 = 0; q4 < 4; ++q4) { const int u = (bun - 128) * 4 + q4, b = u >> 4, h = u & 15;
                        ssd_unit(lds, P1, DTB, b * 256, 256, b, false, h, j, ssd_conv_w, ssd_conv_b, ssd_a_log, ssd_dt_bias, ssd_d, st_ssd_f, st_ssd_b, outSF, outSB, YF, YB); } }
                }
                __syncthreads();
                const float lam_init = (l == 0) ? 0.2f : 0.47071302f;
                for (int rep = 0; rep < REP_ATTN; ++rep)
                for (int bun = vbx; bun < 256; bun += G) {
                    if (!EN_ATTN) break;
                    for (int q2 = 0; q2 < 2; ++q2) { const int u = bun * 2 + q2, qb = u & 7, h = (u >> 3) & 7, b = u >> 6;
                        attn_unit(lds, P1, KCB + (size_t)b * 524288, KCB + 4194304 + (size_t)b * 524288, NPROMPT + b * 1024, 512, 1024, NPROMPT + b * 1024 + qb * 128, h, diff_lambda + j * 256, lam_init, diff_norm_g + j * 128, A2); }
                    for (int q2 = 0; q2 < 2; ++q2) { const int u = bun * 2 + q2, qb = u & 1, h = (u >> 1) & 7, b = u >> 4;
                        attn_unit(lds, P1, nullptr, nullptr, b * 256, 0, 256, b * 256 + qb * 128, h, diff_lambda + j * 256, lam_init, diff_norm_g + j * 128, A2); }
                }
            }
            GRID_SYNC();
            if (STOP_AT == 2) return;
            for (int rep = 0; rep < REP_ELT; ++rep) ssd_gate_phase(YF, YB, P1, ssd_norm_g + j * 1024, A2);
            GRID_SYNC();
            {
                pg8::Gemm g{A2, WOUT_E + (size_t)j * 1024 * 2048, NTOK, 1024, 2048}; pg8::StaticOrder S; S.init(NTOK, 1024, G, bx);
                EpiResid E{X, mod_l + 2 * 1024, HBF, norm_ffn_g + l * 1024, mod_l + 4 * 1024, PARTB + 262144, l == 0 ? x_prompt : (const float*)X, l == 0 ? x_sample : (const float*)X + (size_t)NPROMPT * 1024};
                pg8::gemm_phase<EpiResid, pg8::StaticOrder, false, true>(lds, g, S, E);
            }
            GRID_SYNC();
        } else {
            {
                pg8::Gemm g{HBF, WIN_O + (size_t)j * 2048 * 1024, NTOK, 2048, 1024}; pg8::StaticOrder S; S.init(NTOK, 2048, G, bx);
                EpiScaledBf16 E{P1, 2048, PARTB, SBB + 101376 + (size_t)j * 18432};
                for (int rep = 0; rep < REP_GP; ++rep) pg8::gemm_phase<EpiScaledBf16, pg8::StaticOrder, true, true>(lds, g, S, E);
            }
            GRID_SYNC();
            for (int rep = 0; rep < REP_LRU; ++rep)
            for (int bun = vbx; bun < 256; bun += G) {
                if (!EN_LRU) break;
                if (bun < 128) { const int b = bun >> 4, kb = bun & 15;
                    lru_unit(lds, P1, NPROMPT + b * 1024, 1024, b, true, kb, j, LRUW, lru_conv_w, lru_conv_b, lru_ba, lru_bx, lru_lambda, st_lru_f, st_lru_b, outLF, outLB, YF, YB);
                } else { for (int q4 = 0; q4 < 4; ++q4) { const int u = (bun - 128) * 4 + q4, b = u >> 4, kb = u & 15;
                    lru_unit(lds, P1, b * 256, 256, b, false, kb, j, LRUW, lru_conv_w, lru_conv_b, lru_ba, lru_bx, lru_lambda, st_lru_f, st_lru_b, outLF, outLB, YF, YB); } }
            }
            GRID_SYNC();
            for (int rep = 0; rep < REP_ELT; ++rep) lru_gate_phase(YF, YB, P1, A2);
            GRID_SYNC();
            {
                pg8::Gemm g{A2, WOUT_O + (size_t)j * 1024 * 1024, NTOK, 1024, 1024}; pg8::StaticOrder S; S.init(NTOK, 1024, G, bx);
                EpiResid E{X, mod_l + 2 * 1024, HBF, norm_ffn_g + l * 1024, mod_l + 4 * 1024, PARTB + 262144, l == 0 ? x_prompt : (const float*)X, l == 0 ? x_sample : (const float*)X + (size_t)NPROMPT * 1024};
                pg8::gemm_phase<EpiResid, pg8::StaticOrder, false, true>(lds, g, S, E);
            }
            GRID_SYNC();
        }
        if (STOP_AT == 3) return;
        {
            pg8::Gemm g{HBF, WUP + (size_t)l * NFF2 * 1024, NTOK, NFF2, 1024}; pg8::StaticOrder S; S.init(NTOK, NFF2, G, bx);
#if FFN_FUSED
            EpiFfnAct E{A2, PARTB + 262144, SBB + 138240 + (size_t)l * 50688, ffn_conv_w + (size_t)l * 3 * NFF2, ffn_conv_b + (size_t)l * NFF2, P1, lds + 131072};
            pg8::gemm_phase<EpiFfnAct, pg8::StaticOrder, true, true>(lds, g, S, E);
#else
            EpiScaledBf16 E{P1, NFF2, PARTB + 262144, SBB + 138240 + (size_t)l * 50688};
            for (int rep = 0; rep < REP_GP; ++rep) pg8::gemm_phase<EpiScaledBf16, pg8::StaticOrder, true, true>(lds, g, S, E);
#endif
        }
        GRID_SYNC();
#if !FFN_FUSED
        for (int rep = 0; rep < REP_ELT; ++rep) ffn_act_phase(P1, ffn_conv_w + (size_t)l * 3 * NFF2, ffn_conv_b + (size_t)l * NFF2, A2);
        GRID_SYNC();
#endif
        {
            pg8::Gemm g{A2, WDN + (size_t)l * 1024 * NFF, NTOK, 1024, NFF}; pg8::StaticOrder S; S.init(NTOK, 1024, G, bx);
#if FFN_FUSED
            for (int ui = 0; ; ++ui) { pg8::Unit uu; if (!S.next(ui, uu)) break; ffn_fix_panel(P1, ffn_conv_w + (size_t)l * 3 * NFF2, ffn_conv_b + (size_t)l * NFF2, A2, uu.pm); }
            asm volatile("s_waitcnt vmcnt(0)" ::: "memory"); __syncthreads();
#endif
            EpiResid E{X, mod_l + 5 * 1024, l < 3 ? HBF : nullptr, norm_mix_g + (size_t)(l < 3 ? l + 1 : l) * 1024, MOD + (size_t)(l < 3 ? l + 1 : l) * 9 * 6144 + 1024, PARTB, (const float*)X, (const float*)X + (size_t)NPROMPT * 1024};
            pg8::gemm_phase<EpiResid, pg8::StaticOrder, false, true>(lds, g, S, E);
        }
        GRID_SYNC();
        if (STOP_AT == 4) return;
    }
    norm_rows<1, false>(nullptr, nullptr, X, final_norm_g, nullptr, 0, nullptr);
}

extern "C" void kernel_launch(void* const* d_in, const int* in_sizes, int n_in, void* d_out, int out_size, void* d_ws, size_t ws_size, hipStream_t stream) {
    static int grid_blocks = 0;
    if (grid_blocks == 0) {
        if (n_in != 38 || ws_size < WS_END) { fprintf(stderr, "kernel_launch: unexpected n_in %d / ws_size %zu\n", n_in, ws_size); grid_blocks = -1; return; }
        int dev = 0, cus = 0, per_cu = 0;
        hipGetDevice(&dev);
        hipDeviceGetAttribute(&cus, hipDeviceAttributeMultiprocessorCount, dev);
        hipFuncSetAttribute((const void*)mega_fwd, hipFuncAttributeMaxDynamicSharedMemorySize, LDS_BYTES);
        hipOccupancyMaxActiveBlocksPerMultiprocessor(&per_cu, (const void*)mega_fwd, 512, LDS_BYTES);
        if (per_cu < 1) { fprintf(stderr, "kernel_launch: occupancy query says %d blocks per CU\n", per_cu); per_cu = 1; }
        if (per_cu > 1) per_cu = 1;
        grid_blocks = cus * per_cu;
        (void)hipGetLastError();
    }
    if (grid_blocks < 0) return;
    (void)hipMemsetAsync((unsigned char*)d_ws + WS_BAR, 0, 16384, stream);
    Params p{};
    for (int i = 0; i < 38; ++i) p.in[i] = (gcfp)d_in[i];
    p.out = (GAS float*)d_out; p.ws = (GAS unsigned char*)d_ws;
    void* args[] = {&p};
    hipError_t e = hipLaunchCooperativeKernel((const void*)mega_fwd, dim3(grid_blocks), dim3(512), args, LDS_BYTES, stream);
    if (e != hipSuccess) fprintf(stderr, "cooperative launch failed: %s (grid %d)\n", hipGetErrorString(e), grid_blocks);
}
```

```cpp
#include <hip/hip_runtime.h>
#include <hip/hip_cooperative_groups.h>
#include <cstdio>
#include <cstdint>
namespace cg = cooperative_groups;
#ifndef EN_G1
#define EN_G1 1
#endif
#ifndef EN_G2
#define EN_G2 1
#endif
#ifndef EN_G3
#define EN_G3 1
#endif
#ifndef REP_SSD
#define REP_SSD 1
#endif
#ifndef REP_ATTN
#define REP_ATTN 1
#endif
#ifndef REP_LRU
#define REP_LRU 1
#endif
#ifndef REP_ELT
#define REP_ELT 1
#endif
#ifndef REP_GP
#define REP_GP 1
#endif
#ifndef REP_P0
#define REP_P0 1
#endif
#ifndef REP_SYNC
#define REP_SYNC 1
#endif
#ifndef FFN_FUSED
#define FFN_FUSED 1
#endif
#ifndef STOP_AT
#define STOP_AT 0
#endif
#ifndef EN_SSD
#define EN_SSD 1
#endif
#ifndef EN_ATTN
#define EN_ATTN 1
#endif
#ifndef EN_LRU
#define EN_LRU 1
#endif
#ifndef EN_GEMM
#define EN_GEMM 1
#endif
#ifndef EN_P0
#define EN_P0 1
#endif
#ifndef EN_ELT
#define EN_ELT 1
#endif

#define LAS __attribute__((address_space(3)))
typedef unsigned short bf16_t;
typedef short bf16x8 __attribute__((ext_vector_type(8)));
typedef float f32x4 __attribute__((ext_vector_type(4)));
typedef float f32x2 __attribute__((ext_vector_type(2)));
typedef unsigned u32x4 __attribute__((ext_vector_type(4)));
typedef unsigned u32x2 __attribute__((ext_vector_type(2)));

constexpr int D = 1024, NTOK = 16384, NPROMPT = 8192;
constexpr int NIN_E = 5632;
constexpr int COL_XBC = 1024, COL_DT = 2304, COL_Q = 2560, COL_K = 3584, COL_V = 4608;
constexpr int NFF2 = 5632, NFF = 2816;
constexpr float EPS = 1e-6f;
constexpr int LDS_BYTES = 147456;
constexpr float QSCALE = 0.125f * 1.4426950408889634f;

constexpr size_t MiB = 1u << 20;
constexpr size_t WS_ROPE = 0;
constexpr size_t WS_BAR = 65536;
constexpr size_t WS_MOD = 1 * MiB;
constexpr size_t WS_LRUW = 2 * MiB;
constexpr size_t WS_DT = 3 * MiB;
constexpr size_t WS_WIN_E = 5 * MiB;
constexpr size_t WS_WOUT_E = 27 * MiB;
constexpr size_t WS_WIN_O = 35 * MiB;
constexpr size_t WS_WOUT_O = 43 * MiB;
constexpr size_t WS_WUP = 47 * MiB;
constexpr size_t WS_WDN = 91 * MiB;
constexpr size_t WS_HBF = 113 * MiB;
constexpr size_t WS_YF = 113 * MiB;
constexpr size_t WS_YB = 145 * MiB;
constexpr size_t WS_P1 = 177 * MiB;
constexpr size_t WS_A2 = 353 * MiB;
constexpr size_t WS_SB = 441 * MiB;
constexpr size_t WS_PART = 443 * MiB;
constexpr size_t WS_END = 445 * MiB;

typedef __bf16 bf16x2_t __attribute__((ext_vector_type(2)));
__device__ __forceinline__ unsigned cvt_pk_bf16(float lo, float hi) { const f32x2 v = {lo, hi}; const bf16x2_t b = __builtin_convertvector(v, bf16x2_t); return __builtin_bit_cast(unsigned, b); }
__device__ __forceinline__ unsigned short f2bf(float f) { return (unsigned short)(cvt_pk_bf16(f, 0.f) & 0xffffu); }
__device__ __forceinline__ float bflo(unsigned u) { return __uint_as_float(u << 16); }
__device__ __forceinline__ float bfhi(unsigned u) { return __uint_as_float(u & 0xffff0000u); }
__device__ __forceinline__ float bf2f(unsigned short h) { return __uint_as_float(((unsigned)h) << 16); }
__device__ __forceinline__ void unpack8(const u32x4 v, float* o) { o[0] = bflo(v.x); o[1] = bfhi(v.x); o[2] = bflo(v.y); o[3] = bfhi(v.y); o[4] = bflo(v.z); o[5] = bfhi(v.z); o[6] = bflo(v.w); o[7] = bfhi(v.w); }
__device__ __forceinline__ u32x4 pack8(const float* v) { u32x4 w; w.x = cvt_pk_bf16(v[0], v[1]); w.y = cvt_pk_bf16(v[2], v[3]); w.z = cvt_pk_bf16(v[4], v[5]); w.w = cvt_pk_bf16(v[6], v[7]); return w; }
__device__ __forceinline__ float shfl_xor_l(float v, int mask, int lane) { return __int_as_float(__builtin_amdgcn_ds_bpermute((lane ^ mask) << 2, __float_as_int(v))); }
__device__ __forceinline__ float shfl_idx_l(float v, int src) { return __int_as_float(__builtin_amdgcn_ds_bpermute(src << 2, __float_as_int(v))); }
__device__ __forceinline__ float x32_sum(float v) { const auto r = __builtin_amdgcn_permlane32_swap(__float_as_uint(v), __float_as_uint(v), false, false); return __uint_as_float(r[0]) + __uint_as_float(r[1]); }
__device__ __forceinline__ float x16_sum(float v) { const auto r = __builtin_amdgcn_permlane16_swap(__float_as_uint(v), __float_as_uint(v), false, false); return __uint_as_float(r[0]) + __uint_as_float(r[1]); }
__device__ __forceinline__ float x32_max(float v) { const auto r = __builtin_amdgcn_permlane32_swap(__float_as_uint(v), __float_as_uint(v), false, false); return fmaxf(__uint_as_float(r[0]), __uint_as_float(r[1])); }
__device__ __forceinline__ float x16_max(float v) { const auto r = __builtin_amdgcn_permlane16_swap(__float_as_uint(v), __float_as_uint(v), false, false); return fmaxf(__uint_as_float(r[0]), __uint_as_float(r[1])); }
#define DPPF(x, ctrl) __int_as_float(__builtin_amdgcn_update_dpp(0, __float_as_int(x), (ctrl), 0xF, 0xF, false))
__device__ __forceinline__ float wave_sum(float v, int) {
    v += DPPF(v, 0xB1); v += DPPF(v, 0x4E); v += DPPF(v, 0x141); v += DPPF(v, 0x140);
    v = x16_sum(v); v = x32_sum(v);
    return v;
}
__device__ __forceinline__ float sigmoidf_(float x) { return 1.f / (1.f + __expf(-x)); }
__device__ __forceinline__ float siluf_(float x) { return x * __builtin_amdgcn_rcpf(1.f + __expf(-x)); }
__device__ __forceinline__ float softplusf_(float x) { return fmaxf(x, 0.f) + __logf(1.f + __expf(-fabsf(x))); }
__device__ __forceinline__ float gelu_tanh(float x) { const float u = 0.7978845608028654f * (x + 0.044715f * x * x * x); return x * __builtin_amdgcn_rcpf(1.f + __expf(-2.f * u)); }
__device__ __forceinline__ int opaque_tid() { int t = threadIdx.x; asm volatile("" : "+v"(t)); return t; }
#define CG_SYNC() for (int rs_ = 0; rs_ < REP_SYNC; ++rs_) do { asm volatile("s_waitcnt vmcnt(0) lgkmcnt(0)" ::: "memory"); grid.sync(); \
    if (__builtin_amdgcn_readfirstlane(threadIdx.x >> 6) == 0) { __builtin_amdgcn_fence(__ATOMIC_ACQUIRE, "agent"); asm volatile("s_waitcnt vmcnt(0)" ::: "memory"); } \
    __syncthreads(); } while (0)
#define GRID_SYNC() for (int rs_ = 0; rs_ < REP_SYNC; ++rs_) { XcdBarrier xb_; xb_.bar = (unsigned*)(WSB + WS_BAR); xb_.x = xb_xcc_id(); xb_.st = (volatile LAS unsigned*)(lds + LDS_BYTES - 16); xcd_barrier(xb_); }
#define LDS_BARRIER() asm volatile("s_waitcnt lgkmcnt(0)\n\ts_barrier" ::: "memory")
#define CBAR() asm volatile("s_waitcnt lgkmcnt(0)" ::: "memory")
#define MFMA16(a, b, c) __builtin_amdgcn_mfma_f32_16x16x32_bf16((a), (b), (c), 0, 0, 0)
__device__ __forceinline__ bf16x8 lds_frag(const LAS unsigned char* p) { return *(const LAS bf16x8*)p; }


#define XB_TMO      128
#define XB_XCNT(j)  (256  + 64 * (j))
#define XB_XSUB(j)  (1280 + 64 * (j))
#define XB_XGEN(j)  (2304 + 64 * (j))
#define XB_TOP      3328
#define XB_TOPGEN   3392
#define XCD_BAR_WORDS 3456
#define XB_SPIN_CAP (1u << 18)
__device__ __forceinline__ unsigned xb_ld(unsigned* p)              { return __hip_atomic_load(p, __ATOMIC_RELAXED, __HIP_MEMORY_SCOPE_AGENT); }
__device__ __forceinline__ unsigned xb_add(unsigned* p, unsigned v) { return __hip_atomic_fetch_add(p, v, __ATOMIC_RELAXED, __HIP_MEMORY_SCOPE_AGENT); }
__device__ __forceinline__ unsigned xb_xcc_id() { return (unsigned)__builtin_amdgcn_s_getreg((3 << 11) | 20) & 0xFu; }
#define XB_SPIN(cond, bar) do { unsigned _sp = 0; while (cond) { __builtin_amdgcn_s_sleep(1); \
    if ((++_sp & 255u) == 0u) { if (xb_ld(&(bar)[XB_TMO])) break; if (_sp > XB_SPIN_CAP) { atomicAdd(&(bar)[XB_TMO], 1u); break; } } } } while (0)
struct XcdBarrier { unsigned* bar; unsigned x; volatile LAS unsigned* st; };
__device__ __forceinline__ XcdBarrier xcd_barrier_post(unsigned* bar, volatile LAS unsigned* st) {
    XcdBarrier b; b.bar = bar; b.x = xb_xcc_id(); b.st = st;
    if (threadIdx.x == 0) (void)xb_add(&bar[XB_XCNT(b.x)], 1u);
    return b;
}
__device__ __forceinline__ void xcd_barrier_complete(unsigned* bar, unsigned x, unsigned& nloc, unsigned& nx) {
    const unsigned G = gridDim.x * gridDim.y * gridDim.z;
    unsigned sum, cnt, mine, sp = 0u;
    for (;;) {
        sum = 0u; cnt = 0u; mine = 0u;
#pragma unroll
        for (unsigned j = 0; j < 16; ++j) { const unsigned c = xb_ld(&bar[XB_XCNT(j)]); sum += c; cnt += (c > 0u) ? 1u : 0u; mine = (j == x) ? c : mine; }
        if (sum == G) break;
        __builtin_amdgcn_s_sleep(1);
        if ((++sp & 255u) == 0u) { if (xb_ld(&bar[XB_TMO])) break; if (sp > XB_SPIN_CAP) { atomicAdd(&bar[XB_TMO], 1u); break; } }
    }
    nloc = mine > 0u ? mine : 1u; nx = cnt > 0u ? cnt : 1u;
}
__device__ __forceinline__ void xcd_barrier(const XcdBarrier& b) {
    asm volatile("s_waitcnt vmcnt(0)" ::: "memory");
    __syncthreads();
    if (threadIdx.x == 0) {
        unsigned* bar = b.bar;
        __builtin_amdgcn_s_waitcnt(0);
        unsigned nloc = b.st[0], nx = b.st[1];
        if (nloc == 0u) { xcd_barrier_complete(bar, b.x, nloc, nx); b.st[0] = nloc; b.st[1] = nx; }
        const unsigned old = xb_add(&bar[XB_XSUB(b.x)], 1u);
        const unsigned gen = old / nloc;
        if (old + 1u == (gen + 1u) * nloc) {
            __builtin_amdgcn_fence(__ATOMIC_RELEASE, "agent");
            asm volatile("s_waitcnt vmcnt(0)" ::: "memory");
            const unsigned og = xb_add(&bar[XB_TOP], 1u);
            const unsigned tg = og / nx;
            if (og + 1u == (tg + 1u) * nx) xb_add(&bar[XB_TOPGEN], 1u);
            else XB_SPIN(xb_ld(&bar[XB_TOPGEN]) == tg, bar);
            __builtin_amdgcn_fence(__ATOMIC_ACQUIRE, "agent");
            xb_add(&bar[XB_XGEN(b.x)], 1u);
            asm volatile("s_waitcnt vmcnt(0)" ::: "memory");
        } else {
            XB_SPIN(xb_ld(&bar[XB_XGEN(b.x)]) == gen, bar);
            __builtin_amdgcn_fence(__ATOMIC_ACQUIRE, "agent");
            asm volatile("s_waitcnt vmcnt(0)" ::: "memory");
        }
    }
    __syncthreads();
}

namespace pg8 {
#define PG8_LAS __attribute__((address_space(3)))
constexpr int BM = 256, BK = 64, HALF = 128, HTB = HALF * BK * 2, STAGE_BYTES = 8 * HTB, NXCD = 8, WGM = 8;
__host__ __device__ __forceinline__ int lds_byte(int r, int c) { const int st = (r >> 4) * 2 + (c >> 5), rr = r & 15, cc = c & 31, ob = rr * 64 + cc * 2; return st * 1024 + (ob ^ (((ob >> 9) & 1) << 5)); }
__host__ __device__ __forceinline__ void stage_rc(int b, int& R, int& C) { const int st = b / 1024, sb = b % 1024, swz = sb ^ (((sb >> 9) & 1) << 5); R = (st >> 1) * 16 + swz / 64; C = (st & 1) * 32 + (swz % 64) / 2; }
__host__ __device__ __forceinline__ int perm32(int rho) { const int n = rho >> 4, i = rho & 15; return 8 * (i >> 2) + 4 * n + (i & 3); }
struct Unit { int pm, pn; };
struct Gemm { const bf16_t* A; const bf16_t* Bt; int M, N, K; };
struct StaticOrder {
    int nM, nN, nwg, G, c;
    __host__ __device__ void init(int M, int N, int G_, int c_) { nM = M / BM; nN = N / BM; nwg = nM * nN; G = G_; c = c_; }
    __host__ __device__ __forceinline__ bool next(int i, Unit& u) const {
        const long L = (long)i * G + c; if (L >= nwg) return false;
        int wgid = (int)L; { const int q = nwg / NXCD, r = nwg % NXCD, xcd = wgid % NXCD, off = wgid / NXCD; wgid = (xcd < r ? xcd * (q + 1) : r * (q + 1) + (xcd - r) * q) + off; }
        const int nig = WGM * nN, gid = wgid / nig, fm = gid * WGM, gsz = (nM - fm) < WGM ? (nM - fm) : WGM;
        u.pm = fm + ((wgid % nig) % gsz); u.pn = (wgid % nig) / gsz; return true;
    }
    __device__ __forceinline__ void a_ready(const Unit&) const {}
    __device__ __forceinline__ void done(const Unit&) const {}
};
template <class Epi, class Sched, bool ALIGN_EPI = false, bool SP2 = false>
__device__ __forceinline__ void gemm_phase(PG8_LAS unsigned char* lds, const Gemm g, const Sched& S, const Epi& E) {
    const int tid = opaque_tid(), wid = __builtin_amdgcn_readfirstlane(tid >> 6), lane = tid & 63, wr = wid >> 2, wc = wid & 3, fr = lane & 15, fq = lane >> 4;
    const int K = g.K, nt = K / BK;
    unsigned voffA[2], voffB[2];
#pragma unroll
    for (int i = 0; i < 2; ++i) { int R, C; stage_rc(tid * 16 + i * 8192, R, C); const int Rb = Epi::PERM ? ((R & ~31) + perm32(R & 31)) : R;
        voffA[i] = (unsigned)(R * K + C) * 2u; voffB[i] = (unsigned)(Rb * K + C) * 2u; }
    const size_t kstep = (size_t)(BK * 2);
    const size_t hstep = (size_t)HALF * K * 2;
    const size_t tstep = 2 * hstep;
    const unsigned ldsw = (unsigned)wid * 1024u;
    const int aoff = lds_byte(wr * 64 + fr, fq * 8), boff = lds_byte(wc * 32 + fr, fq * 8);
#define PG8_SA(b, h) (((b) * 2 + (h)) * HTB)
#define PG8_SB(b, h) ((4 + (b) * 2 + (h)) * HTB)
#define PG8_STAGE(bufoff, gbase, voff) do { _Pragma("unroll") for (int _i = 0; _i < 2; ++_i) \
        __builtin_amdgcn_global_load_lds((const unsigned*)((const char*)(gbase) + (voff)[_i]), (PG8_LAS unsigned*)(lds + (bufoff) + ldsw + _i * 8192), 16, 0, 0); } while (0)
#define PG8_LDA(dst, b, h) do { _Pragma("unroll") for (int m = 0; m < 4; ++m) _Pragma("unroll") for (int k = 0; k < 2; ++k) dst[m][k] = *(const PG8_LAS bf16x8*)(lds + PG8_SA(b, h) + aoff + m * 2048 + k * 1024); } while (0)
#define PG8_LDB(dst, b, h) do { _Pragma("unroll") for (int n = 0; n < 2; ++n) _Pragma("unroll") for (int k = 0; k < 2; ++k) dst[n][k] = *(const PG8_LAS bf16x8*)(lds + PG8_SB(b, h) + boff + n * 2048 + k * 1024); } while (0)
#define PG8_MMA(ai, bj, At, Bt) do { __builtin_amdgcn_s_setprio(1); _Pragma("unroll") for (int m = 0; m < 4; ++m) _Pragma("unroll") for (int n = 0; n < 2; ++n) _Pragma("unroll") for (int k = 0; k < 2; ++k) \
        acc[ai][bj][m][n] = __builtin_amdgcn_mfma_f32_16x16x32_bf16(Bt[n][k], At[m][k], acc[ai][bj][m][n], 0, 0, 0); __builtin_amdgcn_s_setprio(0); } while (0)
#define PG8_WAIT_V(n) asm volatile("s_waitcnt vmcnt(" #n ")" ::: "memory")
#define PG8_WAIT_L(n) asm volatile("s_waitcnt lgkmcnt(" #n ")" ::: "memory")
#define PG8_BAR __builtin_amdgcn_s_barrier()
#define PG8_SCHED __builtin_amdgcn_sched_barrier(0)
    Unit cur, nxt; int ui = 0;
    if (!S.next(0, cur)) return;
    f32x4 acc[2][2][4][2];
#pragma unroll
    for (int a = 0; a < 2; ++a)
#pragma unroll
        for (int b = 0; b < 2; ++b)
#pragma unroll
            for (int m = 0; m < 4; ++m)
#pragma unroll
                for (int n = 0; n < 2; ++n) acc[a][b][m][n] = (f32x4){0.f, 0.f, 0.f, 0.f};
    bf16x8 At[4][2], B0[2][2], B1[2][2];
    const char* cA = (const char*)g.A + (size_t)cur.pm * tstep; const char* cB = (const char*)g.Bt + (size_t)cur.pn * tstep;
    S.a_ready(cur);
    if constexpr (SP2) {
        PG8_STAGE(PG8_SB(0, 0), cB, voffB); PG8_STAGE(PG8_SB(0, 1), cB + hstep, voffB); PG8_STAGE(PG8_SA(0, 0), cA, voffA); PG8_STAGE(PG8_SA(0, 1), cA + hstep, voffA);
        if (wr == 1) PG8_BAR;
        PG8_WAIT_V(2); PG8_BAR;
        PG8_STAGE(PG8_SB(1, 0), cB + kstep, voffB); PG8_STAGE(PG8_SA(1, 0), cA + kstep, voffA); PG8_STAGE(PG8_SB(1, 1), cB + hstep + kstep, voffB);
        PG8_WAIT_V(6); PG8_BAR;
    } else {
        PG8_STAGE(PG8_SB(0, 0), cB, voffB); PG8_STAGE(PG8_SA(0, 0), cA, voffA); PG8_STAGE(PG8_SB(0, 1), cB + hstep, voffB); PG8_STAGE(PG8_SA(0, 1), cA + hstep, voffA);
        if (wr == 1) PG8_BAR;
        PG8_WAIT_V(4); PG8_BAR;
        PG8_STAGE(PG8_SB(1, 0), cB + kstep, voffB); PG8_STAGE(PG8_SA(1, 0), cA + kstep, voffA); PG8_STAGE(PG8_SB(1, 1), cB + hstep + kstep, voffB);
        PG8_WAIT_V(6); PG8_BAR;
    }
    for (;;) {
        const bool has_next = S.next(ui + 1, nxt);
        const char* nA = has_next ? (const char*)g.A + (size_t)nxt.pm * tstep : cA; const char* nB = has_next ? (const char*)g.Bt + (size_t)nxt.pn * tstep : cB;
        for (int t = 0; t < nt; t += 2) {
            const bool last = (t == nt - 2);
            const char* a1 = cA + (size_t)(t + 1) * kstep;
            const char* a2 = last ? nA : cA + (size_t)(t + 2) * kstep; const char* b2 = last ? nB : cB + (size_t)(t + 2) * kstep;
            const char* a3 = a2 + kstep; const char* b3 = b2 + kstep;
            if (last && has_next) S.a_ready(nxt);
            if constexpr (SP2) {
            PG8_LDB(B0, 0, 0); PG8_LDB(B1, 0, 1); PG8_SCHED; PG8_LDA(At, 0, 0); PG8_STAGE(PG8_SA(1, 1), a1 + hstep, voffA);
            PG8_WAIT_V(8); PG8_WAIT_L(0); PG8_BAR; PG8_MMA(0, 0, At, B0); PG8_MMA(0, 1, At, B1); PG8_BAR; PG8_SCHED;
            PG8_LDA(At, 0, 1); PG8_STAGE(PG8_SB(0, 0), b2, voffB); PG8_STAGE(PG8_SB(0, 1), b2 + hstep, voffB); PG8_STAGE(PG8_SA(0, 0), a2, voffA);
            PG8_WAIT_V(8); PG8_WAIT_L(0); PG8_BAR; PG8_MMA(1, 0, At, B0); PG8_MMA(1, 1, At, B1); PG8_BAR; PG8_SCHED;
            PG8_LDB(B0, 1, 0); PG8_LDB(B1, 1, 1); PG8_SCHED; PG8_LDA(At, 1, 0); PG8_STAGE(PG8_SA(0, 1), a2 + hstep, voffA);
            PG8_WAIT_V(8); PG8_WAIT_L(0); PG8_BAR; PG8_MMA(0, 0, At, B0); PG8_MMA(0, 1, At, B1); PG8_BAR; PG8_SCHED;
            PG8_LDA(At, 1, 1); PG8_STAGE(PG8_SB(1, 0), b3, voffB); PG8_STAGE(PG8_SB(1, 1), b3 + hstep, voffB); PG8_STAGE(PG8_SA(1, 0), a3, voffA);
            PG8_WAIT_V(8); PG8_WAIT_L(0); PG8_BAR; PG8_MMA(1, 0, At, B0); PG8_MMA(1, 1, At, B1); PG8_BAR; PG8_SCHED;
            } else {
            PG8_LDB(B0, 0, 0); PG8_SCHED; PG8_LDA(At, 0, 0); PG8_STAGE(PG8_SA(1, 1), a1 + hstep, voffA);
            PG8_WAIT_L(8); PG8_BAR; PG8_WAIT_L(0); PG8_MMA(0, 0, At, B0); PG8_BAR; PG8_SCHED;
            PG8_LDB(B1, 0, 1); PG8_STAGE(PG8_SB(0, 0), b2, voffB);
            PG8_BAR; PG8_WAIT_L(0); PG8_MMA(0, 1, At, B1); PG8_BAR;
            PG8_LDA(At, 0, 1); PG8_STAGE(PG8_SA(0, 0), a2, voffA);
            PG8_BAR; PG8_WAIT_L(0); PG8_MMA(1, 0, At, B0); PG8_BAR; PG8_SCHED;
            PG8_STAGE(PG8_SB(0, 1), b2 + hstep, voffB);
            PG8_WAIT_V(6); PG8_BAR; PG8_MMA(1, 1, At, B1); PG8_BAR;
            PG8_LDB(B0, 1, 0); PG8_SCHED; PG8_LDA(At, 1, 0); PG8_STAGE(PG8_SA(0, 1), a2 + hstep, voffA);
            PG8_WAIT_L(8); PG8_BAR; PG8_WAIT_L(0); PG8_MMA(0, 0, At, B0); PG8_BAR; PG8_SCHED;
            PG8_LDB(B1, 1, 1); PG8_STAGE(PG8_SB(1, 0), b3, voffB);
            PG8_BAR; PG8_WAIT_L(0); PG8_MMA(0, 1, At, B1); PG8_BAR;
            PG8_LDA(At, 1, 1); PG8_STAGE(PG8_SA(1, 0), a3, voffA);
            PG8_BAR; PG8_WAIT_L(0); PG8_MMA(1, 0, At, B0); PG8_BAR; PG8_SCHED;
            PG8_STAGE(PG8_SB(1, 1), b3 + hstep, voffB);
            PG8_WAIT_V(6); PG8_BAR; PG8_MMA(1, 1, At, B1); PG8_BAR;
            }
        }
        if constexpr (ALIGN_EPI) { if (wr == 0) PG8_BAR; }
        E(acc, cur, wr, wc, fr, fq);
        if (!has_next) break;
#pragma unroll
        for (int a = 0; a < 2; ++a)
#pragma unroll
            for (int b = 0; b < 2; ++b)
#pragma unroll
                for (int m = 0; m < 4; ++m)
#pragma unroll
                    for (int n = 0; n < 2; ++n) acc[a][b][m][n] = (f32x4){0.f, 0.f, 0.f, 0.f};
        cur = nxt; cA = nA; cB = nB; ++ui;
        if constexpr (ALIGN_EPI) { if (wr == 1) PG8_BAR; }
    }
    PG8_WAIT_V(0);
    if constexpr (!ALIGN_EPI) { if (wr == 0) PG8_BAR; }
    PG8_BAR;
#undef PG8_SA
#undef PG8_SB
#undef PG8_STAGE
#undef PG8_LDA
#undef PG8_LDB
#undef PG8_MMA
#undef PG8_WAIT_V
#undef PG8_WAIT_L
#undef PG8_BAR
#undef PG8_SCHED
}
}

__device__ __forceinline__ float row_rstd(const float* PART, int row, int fq, int lane) {
    const f32x4 p = *(const f32x4*)(PART + (size_t)row * 16 + 4 * fq); float sacc = (p.x + p.y) + (p.z + p.w);
    sacc = x16_sum(sacc); sacc = x32_sum(sacc);
    return rsqrtf(sacc * (1.f / D) + EPS);
}
struct EpiScaledBf16 {
    static constexpr bool PERM = true, AFTER_DRAIN = false;
    bf16_t* O; int ldc; const float* PART; const float* SB;
    __device__ __forceinline__ void operator()(const f32x4 (&acc)[2][2][4][2], const pg8::Unit& u, int wr, int wc, int fr, int fq) const {
        asm volatile("" : "+v"(fr), "+v"(fq));
        const int row0 = u.pm * 256 + wr * 64 + fr, col0 = u.pn * 256 + wc * 32 + 8 * fq;
        const int cond = u.pm < 32 ? 0 : 1 + ((u.pm - 32) >> 2);
        const float* sp = SB + (size_t)cond * ldc + col0;
        f32x4 sb[2][2];
#pragma unroll
        for (int bj = 0; bj < 2; ++bj) { sb[bj][0] = *(const f32x4*)(sp + bj * 128); sb[bj][1] = *(const f32x4*)(sp + bj * 128 + 4); }
        float rsv[2][4];
#pragma unroll
        for (int ai = 0; ai < 2; ++ai)
#pragma unroll
            for (int m = 0; m < 4; ++m) rsv[ai][m] = row_rstd(PART, row0 + ai * 128 + m * 16, fq, fr + 16 * fq);
#pragma unroll
        for (int ai = 0; ai < 2; ++ai)
#pragma unroll
            for (int m = 0; m < 4; ++m) { const int row = row0 + ai * 128 + m * 16; const float rs = rsv[ai][m];
                bf16_t* rowp = O + (size_t)row * ldc + col0;
#pragma unroll
                for (int bj = 0; bj < 2; ++bj) { const f32x4 v0 = acc[ai][bj][m][0] * rs + sb[bj][0], v1 = acc[ai][bj][m][1] * rs + sb[bj][1];
                    u32x4 w; w.x = cvt_pk_bf16(v0[0], v0[1]); w.y = cvt_pk_bf16(v0[2], v0[3]); w.z = cvt_pk_bf16(v1[0], v1[1]); w.w = cvt_pk_bf16(v1[2], v1[3]);
                    *(u32x4*)(rowp + bj * 128) = w; }
                asm volatile("" ::: "memory"); }
    }
};
struct EpiResid {
    static constexpr bool PERM = true, AFTER_DRAIN = false;
    float* X; const float* gate_base;
    bf16_t* XG; const float* g_next; const float* scale_next; float* PART;
    const float* XinP; const float* XinS;
    __device__ __forceinline__ void operator()(const f32x4 (&acc)[2][2][4][2], const pg8::Unit& u, int wr, int wc, int fr, int fq) const {
        asm volatile("" : "+v"(fr), "+v"(fq));
        const int row0 = u.pm * 256 + wr * 64 + fr, col0 = u.pn * 256 + wc * 32 + 8 * fq;
        const int cond = u.pm < 32 ? 0 : 1 + ((u.pm - 32) >> 2);
        const float* gp = gate_base + (size_t)cond * 6144 + col0;
        const bool nxt = XG != nullptr;
        f32x4 gv[2][2], gs[2][2];
#pragma unroll
        for (int bj = 0; bj < 2; ++bj)
#pragma unroll
            for (int n = 0; n < 2; ++n) { gv[bj][n] = *(const f32x4*)(gp + bj * 128 + n * 4);
                gs[bj][n] = nxt ? *(const f32x4*)(g_next + col0 + bj * 128 + n * 4) * (*(const f32x4*)(scale_next + (size_t)cond * 6144 + col0 + bj * 128 + n * 4) + 1.f) : (f32x4){0.f, 0.f, 0.f, 0.f}; }
        f32x4 xin[2][4];
#define ER_LOAD(slot, gi) do { const float* rp_ = xin_ + (size_t)(row0 + ((gi) >> 2) * 128 + ((gi) & 3) * 16) * 1024 + col0; \
        xin[slot][0] = *(const f32x4*)rp_; xin[slot][1] = *(const f32x4*)(rp_ + 4); xin[slot][2] = *(const f32x4*)(rp_ + 128); xin[slot][3] = *(const f32x4*)(rp_ + 132); } while (0)
        const float* xin_ = u.pm < 32 ? XinP : XinS - (size_t)NPROMPT * 1024;
        ER_LOAD(0, 0);
#pragma unroll
        for (int gi = 0; gi < 8; ++gi) { const int ai = gi >> 2, m = gi & 3, sl = gi & 1;
            if (gi + 1 < 8) ER_LOAD((gi + 1) & 1, gi + 1);
            asm volatile("" ::: "memory");
            const int row = row0 + ai * 128 + m * 16; float* rowp = X + (size_t)row * 1024 + col0; float ss = 0.f;
#pragma unroll
            for (int bj = 0; bj < 2; ++bj) {
                const f32x4 o0 = xin[sl][2 * bj] + gv[bj][0] * acc[ai][bj][m][0], o1 = xin[sl][2 * bj + 1] + gv[bj][1] * acc[ai][bj][m][1];
                *(f32x4*)(rowp + bj * 128) = o0; *(f32x4*)(rowp + bj * 128 + 4) = o1;
                if (nxt) { ss += ((o0.x * o0.x + o0.y * o0.y) + (o0.z * o0.z + o0.w * o0.w)) + ((o1.x * o1.x + o1.y * o1.y) + (o1.z * o1.z + o1.w * o1.w));
                    const f32x4 x0 = o0 * gs[bj][0], x1 = o1 * gs[bj][1];
                    u32x4 w; w.x = cvt_pk_bf16(x0.x, x0.y); w.y = cvt_pk_bf16(x0.z, x0.w); w.z = cvt_pk_bf16(x1.x, x1.y); w.w = cvt_pk_bf16(x1.z, x1.w);
                    *(u32x4*)(XG + (size_t)row * 1024 + col0 + bj * 128) = w; } }
            if (nxt) { ss = x16_sum(ss); ss = x32_sum(ss); if (fq == 0) PART[(size_t)row * 16 + u.pn * 4 + wc] = ss; }
        }
#undef ER_LOAD
    }
};
#define DPPU_ROR1(x) ((unsigned)__builtin_amdgcn_update_dpp(0, (int)(x), 0x121, 0xF, 0xF, false))
#define DPPU_ROL1(x) ((unsigned)__builtin_amdgcn_update_dpp(0, (int)(x), 0x12F, 0xF, 0xF, false))
struct EpiFfnAct {
    static constexpr bool PERM = true, AFTER_DRAIN = false;
    bf16_t* A2; const float* PART; const float* SB; const float* cw; const float* cb; bf16_t* EDGE; LAS unsigned char* xch;
    __device__ __forceinline__ void operator()(f32x4 (&acc)[2][2][4][2], const pg8::Unit& u, int wr, int wc, int, int) const {
        const int t_ = opaque_tid(), fr = t_ & 15, fq = (t_ >> 4) & 3;
        const int row0 = u.pm * 256 + wr * 64 + fr;
        const int cc0 = wc * 32 + 8 * fq, ucol = u.pn * 256 + cc0, chan = u.pn * 128 + cc0;
        const int cond = u.pm < 32 ? 0 : 1 + ((u.pm - 32) >> 2);
        unsigned pu[2][2][4][2][2];
        {
            const float* sp = SB + (size_t)cond * NFF2 + ucol;
            f32x4 sb[2][2];
#pragma unroll
            for (int bj = 0; bj < 2; ++bj) { sb[bj][0] = *(const f32x4*)(sp + bj * 128); sb[bj][1] = *(const f32x4*)(sp + bj * 128 + 4); }
            float rsv[2][4];
#pragma unroll
            for (int ai = 0; ai < 2; ++ai)
#pragma unroll
                for (int m = 0; m < 4; ++m) rsv[ai][m] = row_rstd(PART, row0 + ai * 128 + m * 16, fq, fr + 16 * fq);
#pragma unroll
            for (int ai = 0; ai < 2; ++ai)
#pragma unroll
                for (int m = 0; m < 4; ++m)
#pragma unroll
                    for (int bj = 0; bj < 2; ++bj)
#pragma unroll
                        for (int n = 0; n < 2; ++n) { const f32x4 v = acc[ai][bj][m][n] * rsv[ai][m] + sb[bj][n]; pu[ai][bj][m][n][0] = cvt_pk_bf16(v[0], v[1]); pu[ai][bj][m][n][1] = cvt_pk_bf16(v[2], v[3]); }
        }
        if (u.pm >= 32) {
            bf16_t* eb = EDGE + (size_t)(u.pm - 32) * 4 * NFF2 + ucol;
            if (wr == 0 && fr < 2) {
#pragma unroll
                for (int bj = 0; bj < 2; ++bj)
#pragma unroll
                    for (int n = 0; n < 2; ++n) *(u32x2*)(eb + (size_t)fr * NFF2 + bj * 128 + 4 * n) = (u32x2){pu[0][bj][0][n][0], pu[0][bj][0][n][1]}; }
            if (wr == 1 && fr >= 14) {
#pragma unroll
                for (int bj = 0; bj < 2; ++bj)
#pragma unroll
                    for (int n = 0; n < 2; ++n) *(u32x2*)(eb + (size_t)(fr - 12) * NFF2 + bj * 128 + 4 * n) = (u32x2){pu[1][bj][3][n][0], pu[1][bj][3][n][1]}; }
        }
        LAS u32x2* X2 = (LAS u32x2*)xch; const int wave = wr * 4 + wc;
        if (fr == 0) {
#pragma unroll
            for (int ai = 0; ai < 2; ++ai)
#pragma unroll
                for (int bj = 0; bj < 2; ++bj)
#pragma unroll
                    for (int n = 0; n < 2; ++n) X2[((((wave * 2 + ai) * 2 + 0) * 4 + bj * 2 + n) * 4) + fq] = (u32x2){pu[ai][bj][0][n][0], pu[ai][bj][0][n][1]}; }
        if (fr == 15) {
#pragma unroll
            for (int ai = 0; ai < 2; ++ai)
#pragma unroll
                for (int bj = 0; bj < 2; ++bj)
#pragma unroll
                    for (int n = 0; n < 2; ++n) X2[((((wave * 2 + ai) * 2 + 1) * 4 + bj * 2 + n) * 4) + fq] = (u32x2){pu[ai][bj][3][n][0], pu[ai][bj][3][n][1]}; }
        asm volatile("s_waitcnt lgkmcnt(0)\n\ts_barrier" ::: "memory");
        const LAS unsigned* XU = (const LAS unsigned*)xch;
#pragma unroll
        for (int n = 0; n < 2; ++n) {
#pragma unroll
            for (int ai = 0; ai < 2; ++ai) {
                const bool hasp = !(wr == 0 && ai == 0), hasn = !(wr == 1 && ai == 1);
                const int pw = wr == 1 ? wc : 4 + wc, pa = wr == 1 ? ai : 0;
                const int nw = wr == 0 ? 4 + wc : wc, na = wr == 0 ? ai : 1;
                const int pbase = (((((pw * 2 + pa) * 2 + 1) * 4 + n) * 4) + fq) * 2, nbase = (((((nw * 2 + na) * 2 + 0) * 4 + n) * 4) + fq) * 2;
                unsigned op[4][2];
#pragma unroll
                for (int ep = 0; ep < 2; ++ep) {
                    const int c2 = chan + 4 * n + 2 * ep;
                    const f32x2 wv0 = *(const f32x2*)(cw + c2), wv1 = *(const f32x2*)(cw + NFF2 + c2), wv2 = *(const f32x2*)(cw + 2 * NFF2 + c2), bvv = *(const f32x2*)(cb + c2);
                    const f32x2 wg0 = *(const f32x2*)(cw + NFF + c2), wg1 = *(const f32x2*)(cw + NFF2 + NFF + c2), wg2 = *(const f32x2*)(cw + 2 * NFF2 + NFF + c2), bgv = *(const f32x2*)(cb + NFF + c2);
                    float vc[4][2], gc[4][2];
#pragma unroll
                    for (int bj = 0; bj < 2; ++bj) {
                        const unsigned pe = hasp ? XU[pbase + bj * 16 + ep] : 0u, ne = hasn ? XU[nbase + bj * 16 + ep] : 0u;
                        const f32x2 w0 = bj == 0 ? wv0 : wg0, w1 = bj == 0 ? wv1 : wg1, w2 = bj == 0 ? wv2 : wg2, bb = bj == 0 ? bvv : bgv;
#pragma unroll
                        for (int m = 0; m < 4; ++m) {
                            const unsigned am = pu[ai][bj][m][n][ep];
                            const unsigned rm = DPPU_ROR1(am), lm = DPPU_ROL1(am);
                            const unsigned rp = m > 0 ? DPPU_ROR1(pu[ai][bj][m > 0 ? m - 1 : 0][n][ep]) : pe;
                            const unsigned ln = m < 3 ? DPPU_ROL1(pu[ai][bj][m < 3 ? m + 1 : 3][n][ep]) : ne;
                            const unsigned pm_ = fr == 0 ? rp : rm, qm_ = fr == 15 ? ln : lm;
                            const float r0 = bb.x + w0.x * bflo(pm_) + w1.x * bflo(am) + w2.x * bflo(qm_), r1 = bb.y + w0.y * bfhi(pm_) + w1.y * bfhi(am) + w2.y * bfhi(qm_);
                            if (bj == 0) { vc[m][0] = r0; vc[m][1] = r1; } else { gc[m][0] = r0; gc[m][1] = r1; }
                        }
                    }
#pragma unroll
                    for (int m = 0; m < 4; ++m) op[m][ep] = cvt_pk_bf16(siluf_(gc[m][0]) * vc[m][0], siluf_(gc[m][1]) * vc[m][1]);
                }
#pragma unroll
                for (int m = 0; m < 4; ++m) *(u32x2*)(A2 + (size_t)(row0 + ai * 128 + m * 16) * NFF + chan + 4 * n) = (u32x2){op[m][0], op[m][1]};
                asm volatile("" ::: "memory");
            }
        }
    }
};
__device__ __forceinline__ void ffn_fix_phase(const bf16_t* EDGE, const float* cw, const float* cb, bf16_t* A2) {
    const int gtid = blockIdx.x * 512 + opaque_tid(), nthreads = gridDim.x * 512;
    for (int it = gtid; it < 8 * 3 * 2 * (NFF / 8); it += nthreads) {
        const int cg8 = it % (NFF / 8), r = it / (NFF / 8), which = r & 1, bnd = (r >> 1) % 3, b = r / 6;
        const int c = cg8 * 8, ucol = 256 * (c >> 7) + (c & 127);
        const int tA = b * 4 + bnd, tB = tA + 1;
        const bf16_t* pr = EDGE + ((size_t)tA * 4 + (which == 0 ? 2 : 3)) * NFF2 + ucol;
        const bf16_t* cr = which == 0 ? EDGE + ((size_t)tA * 4 + 3) * NFF2 + ucol : EDGE + ((size_t)tB * 4 + 0) * NFF2 + ucol;
        const bf16_t* nr = EDGE + ((size_t)tB * 4 + (which == 0 ? 0 : 1)) * NFF2 + ucol;
        const int grow = NPROMPT + b * 1024 + (bnd + 1) * 256 - 1 + which;
        float pv[8], pg[8], cv[8], cgv[8], nv[8], ng[8], o[8];
        unpack8(*(const u32x4*)pr, pv); unpack8(*(const u32x4*)(pr + 128), pg); unpack8(*(const u32x4*)cr, cv); unpack8(*(const u32x4*)(cr + 128), cgv);
        unpack8(*(const u32x4*)nr, nv); unpack8(*(const u32x4*)(nr + 128), ng);
#pragma unroll
        for (int e = 0; e < 8; ++e) {
            const float val = cb[c + e] + cw[c + e] * pv[e] + cw[NFF2 + c + e] * cv[e] + cw[2 * NFF2 + c + e] * nv[e];
            const float gg = cb[NFF + c + e] + cw[NFF + c + e] * pg[e] + cw[NFF2 + NFF + c + e] * cgv[e] + cw[2 * NFF2 + NFF + c + e] * ng[e];
            o[e] = siluf_(gg) * val; }
        *(u32x4*)(A2 + (size_t)grow * NFF + c) = pack8(o);
    }
}
__device__ __forceinline__ void ffn_fix_row(const bf16_t* EDGE, const float* cw, const float* cb, bf16_t* A2, int tA, int which, int c) {
    const int ucol = 256 * (c >> 7) + (c & 127), tB = tA + 1;
    const bf16_t* pr = EDGE + ((size_t)tA * 4 + (which == 0 ? 2 : 3)) * NFF2 + ucol;
    const bf16_t* cr = which == 0 ? EDGE + ((size_t)tA * 4 + 3) * NFF2 + ucol : EDGE + ((size_t)tB * 4 + 0) * NFF2 + ucol;
    const bf16_t* nr = EDGE + ((size_t)tB * 4 + (which == 0 ? 0 : 1)) * NFF2 + ucol;
    const int grow = NPROMPT + (tA + 1) * 256 - 1 + which;
    float pv[8], pg[8], cv[8], cgv[8], nv[8], ng[8], o[8];
    unpack8(*(const u32x4*)pr, pv); unpack8(*(const u32x4*)(pr + 128), pg); unpack8(*(const u32x4*)cr, cv); unpack8(*(const u32x4*)(cr + 128), cgv);
    unpack8(*(const u32x4*)nr, nv); unpack8(*(const u32x4*)(nr + 128), ng);
#pragma unroll
    for (int e = 0; e < 8; ++e) {
        const float val = cb[c + e] + cw[c + e] * pv[e] + cw[NFF2 + c + e] * cv[e] + cw[2 * NFF2 + c + e] * nv[e];
        const float gg = cb[NFF + c + e] + cw[NFF + c + e] * pg[e] + cw[NFF2 + NFF + c + e] * cgv[e] + cw[2 * NFF2 + NFF + c + e] * ng[e];
        o[e] = siluf_(gg) * val; }
    *(u32x4*)(A2 + (size_t)grow * NFF + c) = pack8(o);
}
__device__ __forceinline__ void ffn_fix_panel(const bf16_t* EDGE, const float* cw, const float* cb, bf16_t* A2, int pm) {
    if (pm < 32) return;
    const int t = pm - 32, k = t & 3, tid = opaque_tid();
    for (int it = tid; it < 2 * (NFF / 8); it += 512) { const int which = it / (NFF / 8), c = (it % (NFF / 8)) * 8;
        if (which == 1 && k > 0) ffn_fix_row(EDGE, cw, cb, A2, t - 1, 1, c);
        if (which == 0 && k < 3) ffn_fix_row(EDGE, cw, cb, A2, t, 0, c); }
}
struct EpiInEven {
    static constexpr bool PERM = true, AFTER_DRAIN = false;
    bf16_t* P1; float* DT; float* outK; float* outV; const float* rope; int j; const float* PART; const float* SB;
    __device__ __forceinline__ void operator()(const f32x4 (&acc)[2][2][4][2], const pg8::Unit& u, int wr, int wc, int fr, int fq) const {
        asm volatile("" : "+v"(fr), "+v"(fq));
        const int pn = u.pn; const int row0 = u.pm * 256 + wr * 64 + fr, col0 = pn * 256 + wc * 32 + 8 * fq;
        const bool sample = u.pm >= 32;
        const int cond = u.pm < 32 ? 0 : 1 + ((u.pm - 32) >> 2);
        const float* sp = SB + (size_t)cond * NIN_E + col0;
        if (pn == 9) {
            if (wc == 0) { const f32x4 sb0 = *(const f32x4*)sp, sb1 = *(const f32x4*)(sp + 4);
#pragma unroll
                for (int ai = 0; ai < 2; ++ai)
#pragma unroll
                    for (int m = 0; m < 4; ++m) { const int row = row0 + ai * 128 + m * 16; const float rs = row_rstd(PART, row, fq, fr + 16 * fq); float* dp = DT + (size_t)row * 32 + 8 * fq;
                        *(f32x4*)dp = acc[ai][0][m][0] * rs + sb0; *(f32x4*)(dp + 4) = acc[ai][0][m][1] * rs + sb1; }
            }
            return;
        }
        f32x4 sb[2][2];
#pragma unroll
        for (int bj = 0; bj < 2; ++bj) { sb[bj][0] = *(const f32x4*)(sp + bj * 128); sb[bj][1] = *(const f32x4*)(sp + bj * 128 + 4); }
        const bool rope_on = sample && pn >= 10 && pn < 18;
        const bool kv_out = (!sample) && pn >= 14;
        float* ob = nullptr; int ocol = 0;
        if (kv_out) { ob = pn < 18 ? outK : outV; ocol = col0 - (pn < 18 ? COL_K : COL_V); }
#pragma unroll
        for (int ai = 0; ai < 2; ++ai) {
            float rsv[4];
#pragma unroll
            for (int m = 0; m < 4; ++m) rsv[m] = row_rstd(PART, row0 + ai * 128 + m * 16, fq, fr + 16 * fq);
#pragma unroll
            for (int m = 0; m < 4; ++m) {
                const int row = row0 + ai * 128 + m * 16; const float rs = rsv[m];
                f32x4 cs0 = {1.f, 1.f, 1.f, 1.f}, cs1 = cs0, sn0 = {0.f, 0.f, 0.f, 0.f}, sn1 = sn0;
                if (rope_on) { const int t = (row - NPROMPT) & 1023; const int pos = (wc & 1) ? (t & 63) : (t >> 6);
                    const float* rp = rope + pos * 16 + 8 * (fq & 1);
                    cs0 = *(const f32x4*)rp; cs1 = *(const f32x4*)(rp + 4); sn0 = *(const f32x4*)(rp + 1024); sn1 = *(const f32x4*)(rp + 1024 + 4); }
                bf16_t* rowp = P1 + (size_t)row * NIN_E + col0;
#pragma unroll
                for (int bj = 0; bj < 2; ++bj) { f32x4 v0 = acc[ai][bj][m][0] * rs + sb[bj][0], v1 = acc[ai][bj][m][1] * rs + sb[bj][1];
                    if (rope_on) {
                        f32x4 p0, p1;
#pragma unroll
                        for (int e = 0; e < 4; ++e) { p0[e] = shfl_xor_l(v0[e], 32, fr + 16 * fq); p1[e] = shfl_xor_l(v1[e], 32, fr + 16 * fq); }
                        if (fq < 2) { v0 = v0 * cs0 - p0 * sn0; v1 = v1 * cs1 - p1 * sn1; }
                        else        { v0 = p0 * sn0 + v0 * cs0; v1 = p1 * sn1 + v1 * cs1; }
                    }
                    if (pn >= 10 && pn < 14) { v0 = v0 * QSCALE; v1 = v1 * QSCALE; }
                    u32x4 w; w.x = cvt_pk_bf16(v0[0], v0[1]); w.y = cvt_pk_bf16(v0[2], v0[3]); w.z = cvt_pk_bf16(v1[0], v1[1]); w.w = cvt_pk_bf16(v1[2], v1[3]);
                    *(u32x4*)(rowp + bj * 128) = w;
                    if (kv_out) { const int b = row >> 8, t = row & 255; float* op = ob + ((size_t)(b * 2 + j) * 256 + t) * 1024 + ocol + bj * 128;
                        *(f32x4*)op = v0; *(f32x4*)(op + 4) = v1; }
                }
                asm volatile("" ::: "memory");
            }
        }
    }
};

#define GAS __attribute__((address_space(1)))
typedef const GAS float* gcfp;
struct Params {
    gcfp in[38];
    GAS float* out;
    GAS unsigned char* ws;
};

__device__ __forceinline__ void transpose_item(const float* W, int K, int N, bf16_t* WT, int row_shift_from, int row_shift, LAS float* scr, int item, int lane) {
    const int nblk = N / 32, kb = item / nblk, nb = item % nblk, k0 = 64 * kb, n0 = 32 * nb;
    float tv[32];
#pragma unroll
    for (int i = 0; i < 32; ++i) { const int kk = 2 * i + (lane >> 5); tv[i] = W[(size_t)(k0 + kk) * N + n0 + (lane & 31)]; }
#pragma unroll
    for (int i = 0; i < 32; ++i) { const int kk = 2 * i + (lane >> 5); scr[kk * 33 + (lane & 31)] = tv[i]; }
    CBAR();
    const int c = lane & 7;
    const int drow0 = row_shift_from < 0 ? (n0 < NFF ? 256 * (n0 / 128) + (n0 % 128) : 256 * ((n0 - NFF) / 128) + 128 + ((n0 - NFF) % 128)) : n0 + (n0 >= row_shift_from ? row_shift : 0);
#pragma unroll
    for (int jx = 0; jx < 4; ++jx) { const int n = (lane >> 3) + 8 * jx; const LAS float* s = scr + (8 * c) * 33 + n;
        u32x4 o; o.x = cvt_pk_bf16(s[0 * 33], s[1 * 33]); o.y = cvt_pk_bf16(s[2 * 33], s[3 * 33]); o.z = cvt_pk_bf16(s[4 * 33], s[5 * 33]); o.w = cvt_pk_bf16(s[6 * 33], s[7 * 33]);
        *(u32x4*)(WT + (size_t)(drow0 + n) * K + k0 + 8 * c) = o; }
    CBAR();
}

template <int MODE, bool FROM_INPUT>
__device__ __forceinline__ void norm_rows(const float* xp, const float* xs, float* X, const float* g, const float* mod_l, int shift_chunk, bf16_t* hout) {
    const int tid_ = opaque_tid(), lane = tid_ & 63, gw = blockIdx.x * 8 + (tid_ >> 6), NGW = gridDim.x * 8;
    f32x4 gv[4];
#pragma unroll
    for (int jx = 0; jx < 4; ++jx) gv[jx] = *(const f32x4*)(g + 4 * lane + 256 * jx);
    for (int m = gw; m < NTOK; m += NGW) {
        const float* src = FROM_INPUT ? (m < NPROMPT ? xp + (size_t)m * D : xs + (size_t)(m - NPROMPT) * D) : X + (size_t)m * D;
        f32x4 v[4]; float ss = 0.f;
#pragma unroll
        for (int jx = 0; jx < 4; ++jx) { v[jx] = *(const f32x4*)(src + 4 * lane + 256 * jx); ss += (v[jx].x * v[jx].x + v[jx].y * v[jx].y) + (v[jx].z * v[jx].z + v[jx].w * v[jx].w); }
        if (FROM_INPUT) {
#pragma unroll
            for (int jx = 0; jx < 4; ++jx) *(f32x4*)(X + (size_t)m * D + 4 * lane + 256 * jx) = v[jx];
        }
        const float rstd = rsqrtf(wave_sum(ss, lane) * (1.f / D) + EPS);
        if (MODE == 0) {
            const int cond = m < NPROMPT ? 0 : 1 + ((m - NPROMPT) >> 10);
            const float* mp = mod_l + (size_t)cond * 6144 + shift_chunk * 1024;
#pragma unroll
            for (int jx = 0; jx < 4; ++jx) { const f32x4 sh = *(const f32x4*)(mp + 4 * lane + 256 * jx), sc = *(const f32x4*)(mp + 1024 + 4 * lane + 256 * jx);
                const f32x4 y = v[jx] * rstd * gv[jx]; const f32x4 hh = y * (sc + 1.f) + sh;
                u32x2 w; w.x = cvt_pk_bf16(hh.x, hh.y); w.y = cvt_pk_bf16(hh.z, hh.w);
                *(u32x2*)(hout + (size_t)m * D + 4 * lane + 256 * jx) = w; }
        } else {
#pragma unroll
            for (int jx = 0; jx < 4; ++jx) *(f32x4*)(X + (size_t)m * D + 4 * lane + 256 * jx) = v[jx] * rstd * gv[jx];
        }
    }
}

__device__ __forceinline__ void first_rows(const float* xp, const float* xs, float* X, const float* g, const float* mod0, bf16_t* XG, float* PART) {
    const int tid_ = opaque_tid(), lane = tid_ & 63, gw = blockIdx.x * 8 + (tid_ >> 6), NGW = gridDim.x * 8;
    f32x4 gv[4];
#pragma unroll
    for (int jx = 0; jx < 4; ++jx) gv[jx] = *(const f32x4*)(g + 4 * lane + 256 * jx);
    for (int m = gw; m < NTOK; m += NGW) {
        const float* src = m < NPROMPT ? xp + (size_t)m * D : xs + (size_t)(m - NPROMPT) * D;
        f32x4 v[4]; float ss = 0.f;
#pragma unroll
        for (int jx = 0; jx < 4; ++jx) { v[jx] = *(const f32x4*)(src + 4 * lane + 256 * jx); ss += (v[jx].x * v[jx].x + v[jx].y * v[jx].y) + (v[jx].z * v[jx].z + v[jx].w * v[jx].w); }
        ss = wave_sum(ss, lane);
        const int cond = m < NPROMPT ? 0 : 1 + ((m - NPROMPT) >> 10);
        const float* scp = mod0 + (size_t)cond * 6144 + 1024;
#pragma unroll
        for (int jx = 0; jx < 4; ++jx) { const f32x4 sc = *(const f32x4*)(scp + 4 * lane + 256 * jx); const f32x4 xg = v[jx] * gv[jx] * (sc + 1.f);
            u32x2 w; w.x = cvt_pk_bf16(xg.x, xg.y); w.y = cvt_pk_bf16(xg.z, xg.w); *(u32x2*)(XG + (size_t)m * D + 4 * lane + 256 * jx) = w; }
        if (lane < 4) *(f32x4*)(PART + (size_t)m * 16 + 4 * lane) = (f32x4){lane == 0 ? ss : 0.f, 0.f, 0.f, 0.f};
    }
}
__device__ __forceinline__ void sb_gemv_phase(const float* MODp, const bf16_t* WT, int nrows, int lmod, int chunk, float* out, int ostr) {
    const int tid_ = opaque_tid(), lane = tid_ & 63, gw = blockIdx.x * 8 + (tid_ >> 6), NGW = gridDim.x * 8;
    float sh[9][16];
#pragma unroll
    for (int ci = 0; ci < 9; ++ci) { const float* sp = MODp + ((size_t)lmod * 9 + ci) * 6144 + chunk * 1024 + 16 * lane;
#pragma unroll
        for (int q4 = 0; q4 < 4; ++q4) { const f32x4 t = *(const f32x4*)(sp + 4 * q4); sh[ci][4 * q4] = t.x; sh[ci][4 * q4 + 1] = t.y; sh[ci][4 * q4 + 2] = t.z; sh[ci][4 * q4 + 3] = t.w; } }
    for (int n = gw; n < nrows; n += NGW) {
        float w[16]; unpack8(*(const u32x4*)(WT + (size_t)n * 1024 + 16 * lane), w); unpack8(*(const u32x4*)(WT + (size_t)n * 1024 + 16 * lane + 8), w + 8);
        float r[9];
#pragma unroll
        for (int ci = 0; ci < 9; ++ci) { float a = 0.f;
#pragma unroll
            for (int e = 0; e < 16; ++e) a += sh[ci][e] * w[e];
            r[ci] = wave_sum(a, lane); }
        if (lane == 0) {
#pragma unroll
            for (int ci = 0; ci < 9; ++ci) out[(size_t)ci * ostr + n] = r[ci]; }
    }
}

__device__ __forceinline__ void ffn_act_phase(const bf16_t* U, const float* cw, const float* cb, bf16_t* A2) {
    const int gtid = blockIdx.x * 512 + opaque_tid(), nthreads = gridDim.x * 512;
    constexpr int NCG = NFF / 8, RUN = 16, NRUN = NTOK / RUN;
    for (int it = gtid; it < NCG * NRUN; it += nthreads) {
        const int cg8 = it % NCG, run = it / NCG, t0 = run * RUN, col = cg8 * 8;
        const int Lm = t0 < NPROMPT ? 255 : 1023;
        const bool first = (t0 & Lm) == 0, last = ((t0 + RUN) & Lm) == 0;
        float wv[3][8], wg[3][8], bv[8], bg[8];
#pragma unroll
        for (int k = 0; k < 3; ++k) {
#pragma unroll
            for (int e = 0; e < 8; ++e) { wv[k][e] = cw[k * NFF2 + col + e]; wg[k][e] = cw[k * NFF2 + NFF + col + e]; } }
#pragma unroll
        for (int e = 0; e < 8; ++e) { bv[e] = cb[col + e]; bg[e] = cb[NFF + col + e]; }
        float pv[8], pg[8], cv[8], cgv[8], nv[8], ng[8];
        const bf16_t* base = U + (size_t)t0 * NFF2 + 256 * (col >> 7) + (col & 127);
        if (first) {
#pragma unroll
            for (int e = 0; e < 8; ++e) { pv[e] = 0.f; pg[e] = 0.f; } }
        else { unpack8(*(const u32x4*)(base - NFF2), pv); unpack8(*(const u32x4*)(base - NFF2 + 128), pg); }
        unpack8(*(const u32x4*)base, cv); unpack8(*(const u32x4*)(base + 128), cgv);
        for (int i = 0; i < RUN; ++i) {
            if (i == RUN - 1 && last) {
#pragma unroll
                for (int e = 0; e < 8; ++e) { nv[e] = 0.f; ng[e] = 0.f; } }
            else { const bf16_t* nb = base + (size_t)(i + 1) * NFF2; unpack8(*(const u32x4*)nb, nv); unpack8(*(const u32x4*)(nb + 128), ng); }
            float o[8];
#pragma unroll
            for (int e = 0; e < 8; ++e) { const float val = bv[e] + wv[0][e] * pv[e] + wv[1][e] * cv[e] + wv[2][e] * nv[e];
                const float gg = bg[e] + wg[0][e] * pg[e] + wg[1][e] * cgv[e] + wg[2][e] * ng[e]; o[e] = siluf_(gg) * val; }
            *(u32x4*)(A2 + (size_t)(t0 + i) * NFF + col) = pack8(o);
#pragma unroll
            for (int e = 0; e < 8; ++e) { pv[e] = cv[e]; pg[e] = cgv[e]; cv[e] = nv[e]; cgv[e] = ng[e]; }
        }
    }
}

__device__ __forceinline__ void ssd_gate_phase(const bf16_t* YF, const bf16_t* YB, const bf16_t* P1, const float* ng, bf16_t* A2) {
    const int tid_ = opaque_tid(), lane = tid_ & 63, gw = blockIdx.x * 8 + (tid_ >> 6), NGW = gridDim.x * 8;
    for (int m = gw; m < NTOK; m += NGW) {
        float v[2][8]; float ss = 0.f;
#pragma unroll
        for (int jx = 0; jx < 2; ++jx) { const int c = 8 * lane + 512 * jx; float a[8], b[8], z[8];
            unpack8(*(const u32x4*)(YF + (size_t)m * D + c), a); unpack8(*(const u32x4*)(YB + (size_t)m * D + c), b); unpack8(*(const u32x4*)(P1 + (size_t)m * NIN_E + c), z);
#pragma unroll
            for (int e = 0; e < 8; ++e) { const float y = (a[e] + b[e]) * siluf_(z[e]); v[jx][e] = y; ss += y * y; } }
        const float rstd = rsqrtf(wave_sum(ss, lane) * (1.f / D) + EPS);
#pragma unroll
        for (int jx = 0; jx < 2; ++jx) { const int c = 8 * lane + 512 * jx; float o[8];
#pragma unroll
            for (int e = 0; e < 8; ++e) o[e] = v[jx][e] * rstd * ng[c + e];
            *(u32x4*)(A2 + (size_t)m * 2048 + c) = pack8(o); }
    }
}
__device__ __forceinline__ void lru_gate_phase(const bf16_t* YF, const bf16_t* YB, const bf16_t* P1, bf16_t* A2) {
    const int gtid = blockIdx.x * 512 + opaque_tid(), nthreads = gridDim.x * 512;
    for (int it = gtid; it < NTOK * 128; it += nthreads) {
        const int m = it >> 7, c = (it & 127) * 8; float a[8], b[8], gt[8], o[8];
        unpack8(*(const u32x4*)(YF + (size_t)m * D + c), a); unpack8(*(const u32x4*)(YB + (size_t)m * D + c), b); unpack8(*(const u32x4*)(P1 + (size_t)m * 2048 + c), gt);
#pragma unroll
        for (int e = 0; e < 8; ++e) o[e] = (a[e] + b[e]) * gelu_tanh(gt[e]);
        *(u32x4*)(A2 + (size_t)m * D + c) = pack8(o);
    }
}


__device__ __forceinline__ void cache_to_bf16(const float* ck, const float* cv, int j, bf16_t* KC) {
    const int gtid = blockIdx.x * 512 + opaque_tid(), nthreads = gridDim.x * 512;
    for (int it = gtid; it < 2 * 524288; it += nthreads) {
        const int which = it >= 524288, r = it & 524287, b = r >> 16, e8 = r & 65535;
        const float* src = (which ? cv : ck) + ((size_t)(b * 2 + j) * 524288 + (size_t)e8 * 8);
        const f32x4 a = *(const f32x4*)src, c = *(const f32x4*)(src + 4);
        u32x4 w; w.x = cvt_pk_bf16(a.x, a.y); w.y = cvt_pk_bf16(a.z, a.w); w.z = cvt_pk_bf16(c.x, c.y); w.w = cvt_pk_bf16(c.z, c.w);
        *(u32x4*)(KC + (size_t)which * 4194304 + (size_t)b * 524288 + (size_t)e8 * 8) = w;
    }
}

__device__ __forceinline__ void ssd_unit(LAS unsigned char* lds, const bf16_t* P1, const float* DT, int seqrow0, int Lseq, int bidx, bool sample, int h, int j,
                                         const float* conv_w, const float* conv_b, const float* a_log, const float* dt_bias, const float* ssd_d,
                                         const float* st_f, const float* st_b, float* out_f, float* out_b, bf16_t* YF, bf16_t* YB) {
    const int tid = opaque_tid(), wave = __builtin_amdgcn_readfirstlane(tid >> 6), dir = wave >> 2, wq = wave & 3, tg = tid & 255;
    int lane = tid & 63, l15 = lane & 15, lq = lane >> 4;
    LAS unsigned char* base = lds + dir * 65536;
    LAS unsigned char* Cs = base, *Bs = base + 9216, *BTw = base + 18432, *XTs = base + 27648, *Ms = base + 36864;
    const int g = h >> 3;
    const float Aneg = -__expf(a_log[j * 32 + dir * 16 + h]); const float dtb = dt_bias[j * 32 + dir * 16 + h]; const float Dh = ssd_d[j * 16 + h];
    f32x4 Hacc[4];
    {
        const float* st = (dir == 0 ? st_f : st_b) + ((size_t)(bidx * 2 + j) * 16 + h) * 4096;
#pragma unroll
        for (int ni = 0; ni < 4; ++ni)
#pragma unroll
            for (int jj = 0; jj < 4; ++jj) Hacc[ni][jj] = sample ? st[(16 * wq + lq * 4 + jj) * 64 + 16 * ni + l15] : 0.f;
    }
    bf16_t* Y = dir == 0 ? YF : YB;
    const int nch = Lseq >> 6;
    float dtraw = 0.f;
#define SSD_ISSUE(ci) do { const int c_ = dir == 0 ? (ci) : nch - 1 - (ci); const int tb_ = seqrow0 + 64 * c_; \
        if (wq == 0) dtraw = DT[(size_t)(tb_ + lane) * 32 + dir * 16 + h]; } while (0)
#define SSD_PREP(buf) do { LAS unsigned char* Hs_ = base + 46080 + 9216 * (buf); \
        _Pragma("unroll") for (int ni = 0; ni < 4; ++ni) _Pragma("unroll") for (int jj = 0; jj < 4; ++jj) \
            *(LAS unsigned short*)(Hs_ + ((16 * wq + lq * 4 + jj) * 72 + 16 * ni + l15) * 2) = f2bf(Hacc[ni][jj]); \
        if (wq == 0) { const float dtv = softplusf_(dtraw + dtb); const float da = dtv * Aneg; float ps = da; \
            _Pragma("unroll") for (int o = 1; o < 64; o <<= 1) { const float t = shfl_idx_l(ps, lane >= o ? lane - o : lane); if (lane >= o) ps += t; } \
            const float total = shfl_idx_l(ps, 63); \
            ((LAS float*)(base + 64512 + 512 * (buf)))[lane] = dtv; ((LAS float*)(base + 64768 + 512 * (buf)))[lane] = dir == 0 ? ps : (total - ps + da); } } while (0)
    LDS_BARRIER();
    SSD_ISSUE(0);
    SSD_PREP(0);
    for (int i = 0; i < nch; ++i) {
        asm volatile("" : "+v"(lane), "+v"(l15), "+v"(lq));
        const int c = dir == 0 ? i : nch - 1 - i; const int tb = seqrow0 + 64 * c; const int buf = i & 1;
        LAS unsigned char* Hs = base + 46080 + 9216 * buf; LAS float* dts = (LAS float*)(base + 64512 + 512 * buf); LAS float* acss = (LAS float*)(base + 64768 + 512 * buf);
        LDS_BARRIER();
        const float acs_last = acss[dir == 0 ? 63 : 0];
#pragma unroll
        for (int hi = 0; hi < 2; ++hi) {
            if (hi == 1 && wave >= 4) break;
            const int hr = wave < 4 ? 3 * wave + hi : 3 * (wave - 4) + 2;
            const int rdir = hr >= 6 ? 1 : 0, a = (hr - 6 * rdir) >> 1, th = hr & 1;
            const int cgp = a == 0 ? (lane >> 3) : (lane & 7), run = a == 0 ? (lane & 7) : (lane >> 3);
            const int chan = (a == 0 ? h * 64 : (a == 1 ? 1024 + g * 64 : 1152 + g * 64)) + cgp * 8;
            LAS unsigned char* rb = lds + rdir * 65536;
            const LAS float* rdts = (const LAS float*)(rb + 64512 + 512 * buf); const LAS float* racs = (const LAS float*)(rb + 64768 + 512 * buf);
            const int rc = rdir == 0 ? i : nch - 1 - i;
            const float racs_last = racs[rdir == 0 ? 63 : 0];
            const int tl0 = 64 * rc + 8 * run + 4 * th;
            u32x4 raw[7];
#pragma unroll
            for (int r = 0; r < 7; ++r) { const int tt = tl0 - 2 + r;
                raw[r] = (tt >= 0 && tt < Lseq) ? *(const u32x4*)(P1 + (size_t)(seqrow0 + tt) * NIN_E + COL_XBC + chan) : (u32x4){0u, 0u, 0u, 0u}; }
            float wv[4][8], bv[8];
#pragma unroll
            for (int jj = 0; jj < 4; ++jj) { const float* wp = conv_w + (size_t)(j * 4 + jj) * 1280 + chan; const f32x4 w0 = *(const f32x4*)wp, w1 = *(const f32x4*)(wp + 4);
                wv[jj][0] = w0.x; wv[jj][1] = w0.y; wv[jj][2] = w0.z; wv[jj][3] = w0.w; wv[jj][4] = w1.x; wv[jj][5] = w1.y; wv[jj][6] = w1.z; wv[jj][7] = w1.w; }
            { const f32x4 b0 = *(const f32x4*)(conv_b + j * 1280 + chan), b1 = *(const f32x4*)(conv_b + j * 1280 + chan + 4);
              bv[0] = b0.x; bv[1] = b0.y; bv[2] = b0.z; bv[3] = b0.w; bv[4] = b1.x; bv[5] = b1.y; bv[6] = b1.z; bv[7] = b1.w; }
            unsigned pk[8][2];
            float r0[8], r1[8], r2[8], vp[8];
            unpack8(raw[0], r0); unpack8(raw[1], r1); unpack8(raw[2], r2);
#pragma unroll
            for (int tk = 0; tk < 4; ++tk) {
                float r3[8], v[8];
                unpack8(raw[tk + 3], r3);
#pragma unroll
                for (int e = 0; e < 8; ++e) { const float xx = bv[e] + wv[0][e] * r0[e] + wv[1][e] * r1[e] + wv[2][e] * r2[e] + wv[3][e] * r3[e]; v[e] = xx * __builtin_amdgcn_rcpf(1.f + __expf(-xx)); }
                const int k = 8 * run + 4 * th + tk;
                if (a == 1) { *(LAS u32x4*)(rb + 9216 + (k * 72 + cgp * 8) * 2) = pack8(v); const float wk = __expf(racs_last - racs[k]) * rdts[k];
#pragma unroll
                    for (int e = 0; e < 8; ++e) v[e] *= wk; }
                else if (a == 2) *(LAS u32x4*)(rb + (k * 72 + cgp * 8) * 2) = pack8(v);
                if (tk & 1) {
#pragma unroll
                    for (int e = 0; e < 8; ++e) pk[e][tk >> 1] = cvt_pk_bf16(vp[e], v[e]);
                } else {
#pragma unroll
                    for (int e = 0; e < 8; ++e) vp[e] = v[e];
                }
#pragma unroll
                for (int e = 0; e < 8; ++e) { r0[e] = r1[e]; r1[e] = r2[e]; r2[e] = r3[e]; }
                asm volatile("" ::: "memory");
            }
            const int k0r = 8 * run, tpos = ((k0r & 32) | ((k0r & 8) << 1) | ((k0r & 16) >> 2)) + 8 * th;
            if (a < 2) { LAS unsigned char* dstT = rb + (a == 0 ? 27648 : 18432);
#pragma unroll
                for (int e = 0; e < 8; ++e) *(LAS u32x2*)(dstT + ((cgp * 8 + e) * 72 + tpos) * 2) = (u32x2){pk[e][0], pk[e][1]}; }
        }
        if (i + 1 < nch) SSD_ISSUE(i + 1);
        LDS_BARRIER();
        const int q = 16 * wq + l15; const float acs_q = acss[q];
        unsigned mp[4][2];
        {
            bf16x8 cf[2];
#pragma unroll
            for (int kk = 0; kk < 2; ++kk) cf[kk] = lds_frag(Cs + (q * 72 + 32 * kk + lq * 8) * 2);
#pragma unroll
            for (int ni = 0; ni < 4; ++ni) { f32x4 gt = {0.f, 0.f, 0.f, 0.f};
#pragma unroll
                for (int kk = 0; kk < 2; ++kk) gt = MFMA16(lds_frag(Bs + ((16 * ni + l15) * 72 + 32 * kk + lq * 8) * 2), cf[kk], gt);
                float mv[4];
#pragma unroll
                for (int jj = 0; jj < 4; ++jj) { const int k = 16 * ni + 4 * lq + jj; const bool ok = dir == 0 ? (k <= q) : (k >= q);
                    mv[jj] = ok ? gt[jj] * __expf(acs_q - acss[k]) * dts[k] : 0.f; }
                mp[ni][0] = cvt_pk_bf16(mv[0], mv[1]); mp[ni][1] = cvt_pk_bf16(mv[2], mv[3]); }
        }
        {
            bf16x8 mf[2], cf[2];
#pragma unroll
            for (int kk = 0; kk < 2; ++kk) { mf[kk] = __builtin_bit_cast(bf16x8, (u32x4){mp[2 * kk][0], mp[2 * kk][1], mp[2 * kk + 1][0], mp[2 * kk + 1][1]}); cf[kk] = lds_frag(Cs + (q * 72 + 32 * kk + lq * 8) * 2); }
            const float eq = __expf(acs_q); const int qpos = (q & 32) | ((q & 12) << 1) | ((q & 16) >> 2) | (q & 3);
#pragma unroll
            for (int ni = 0; ni < 4; ++ni) { f32x4 yd = {0.f, 0.f, 0.f, 0.f}, yo = yd;
#pragma unroll
                for (int kk = 0; kk < 2; ++kk) { yd = MFMA16(lds_frag(XTs + ((16 * ni + l15) * 72 + 32 * kk + lq * 8) * 2), mf[kk], yd);
                                                 yo = MFMA16(lds_frag(Hs + ((16 * ni + l15) * 72 + 32 * kk + lq * 8) * 2), cf[kk], yo); }
                float yv[4];
#pragma unroll
                for (int jj = 0; jj < 4; ++jj) { yv[jj] = yd[jj] + eq * yo[jj];
                    if (dir == 0) yv[jj] += Dh * bf2f(*(const LAS unsigned short*)(XTs + ((16 * ni + 4 * lq + jj) * 72 + qpos) * 2)); }
                u32x2 w; w.x = cvt_pk_bf16(yv[0], yv[1]); w.y = cvt_pk_bf16(yv[2], yv[3]);
                *(u32x2*)(Y + (size_t)(tb + q) * D + h * 64 + 16 * ni + 4 * lq) = w; }
        }
        {
            const float decay = __expf(acs_last);
            bf16x8 xf[2];
#pragma unroll
            for (int kk = 0; kk < 2; ++kk) xf[kk] = lds_frag(XTs + ((16 * wq + l15) * 72 + 32 * kk + lq * 8) * 2);
#pragma unroll
            for (int ni = 0; ni < 4; ++ni) { Hacc[ni] = Hacc[ni] * decay;
#pragma unroll
                for (int kk = 0; kk < 2; ++kk) Hacc[ni] = MFMA16(xf[kk], lds_frag(BTw + ((16 * ni + l15) * 72 + 32 * kk + lq * 8) * 2), Hacc[ni]); }
        }
        if (i + 1 < nch) SSD_PREP(buf ^ 1);
    }
#undef SSD_ISSUE
#undef SSD_PREP
    if (!sample) {
        float* o = (dir == 0 ? out_f : out_b) + ((size_t)(bidx * 2 + j) * 16 + h) * 4096;
#pragma unroll
        for (int ni = 0; ni < 4; ++ni)
#pragma unroll
            for (int jj = 0; jj < 4; ++jj) o[(16 * wq + lq * 4 + jj) * 64 + 16 * ni + l15] = Hacc[ni][jj];
    }
}

__device__ __forceinline__ void lru_unit(LAS unsigned char* lds, const bf16_t* P1, int seqrow0, int Lseq, int bidx, bool sample, int kb, int jo, const bf16_t* LRUW,
                                         const float* conv_w, const float* conv_b, const float* ba, const float* bx, const float* lam,
                                         const float* st_f, const float* st_b, float* out_f, float* out_b, bf16_t* YF, bf16_t* YB) {
    const int tid = opaque_tid(), wave = __builtin_amdgcn_readfirstlane(tid >> 6), lane = tid & 63, dir = wave >> 2, wq = wave & 3, tg = tid & 255, l15 = lane & 15, lq = lane >> 4;
    LAS unsigned char* base = lds + dir * 65536;
    LAS unsigned char* XC = base, *WA = base + 9216, *WX = base + 18432;
    LAS float* As = (LAS float*)(base + 27648); LAS float* Us = (LAS float*)(base + 44288);
    LDS_BARRIER();
#pragma unroll
    for (int which = 0; which < 2; ++which) {
        const bf16_t* src = LRUW + ((size_t)((jo * 2 + dir) * 2 + which) * 16 + kb) * 4096;
        LAS unsigned char* dst = which == 0 ? WA : WX;
#pragma unroll
        for (int it = 0; it < 2; ++it) { const int idx = it * 256 + tg, r = idx >> 3, cc = idx & 7;
            *(LAS u32x4*)(dst + (r * 72 + cc * 8) * 2) = *(const u32x4*)(src + r * 64 + cc * 8); }
    }
    float bav[4], bxv[4], spl[4];
#pragma unroll
    for (int ni = 0; ni < 4; ++ni) { const int ch = kb * 64 + 16 * ni + l15; bav[ni] = ba[(jo * 2 + dir) * 1024 + ch]; bxv[ni] = bx[(jo * 2 + dir) * 1024 + ch]; spl[ni] = -8.f * softplusf_(-lam[(jo * 2 + dir) * 1024 + ch]); }
    float hst = 0.f;
    if (sample && tg < 64) hst = (dir == 0 ? st_f : st_b)[(size_t)(bidx * 2 + jo) * 1024 + kb * 64 + tg];
    bf16_t* Y = dir == 0 ? YF : YB;
    const int ntile = Lseq >> 6;
    u32x4 rawl[2][4];
#define LRU_ISSUE(ti) do { const int c_ = dir == 0 ? (ti) : ntile - 1 - (ti); const int tb_ = seqrow0 + 64 * c_; \
        _Pragma("unroll") for (int it = 0; it < 2; ++it) { const int idx = it * 256 + tg, k = idx >> 3, cgp = idx & 7; const int tl = tb_ + k - seqrow0; \
            _Pragma("unroll") for (int jj = 0; jj < 4; ++jj) { const int tt = tl - 2 + jj; \
                rawl[it][jj] = (tt >= 0 && tt < Lseq) ? *(const u32x4*)(P1 + (size_t)(seqrow0 + tt) * 2048 + 1024 + kb * 64 + cgp * 8) : (u32x4){0u, 0u, 0u, 0u}; } } } while (0)
    LRU_ISSUE(0);
    f32x4 cwv[4][2], cbv[2];
    { const int chan = kb * 64 + (tg & 7) * 8;
#pragma unroll
      for (int jj = 0; jj < 4; ++jj) { const float* wp = conv_w + (size_t)(jo * 4 + jj) * 1024 + chan; cwv[jj][0] = *(const f32x4*)wp; cwv[jj][1] = *(const f32x4*)(wp + 4); }
      cbv[0] = *(const f32x4*)(conv_b + jo * 1024 + chan); cbv[1] = *(const f32x4*)(conv_b + jo * 1024 + chan + 4); }
    for (int i = 0; i < ntile; ++i) {
        const int c = dir == 0 ? i : ntile - 1 - i; const int tb = seqrow0 + 64 * c;
        LDS_BARRIER();
#pragma unroll
        for (int it = 0; it < 2; ++it) {
            const int idx = it * 256 + tg, k = idx >> 3, cgp = idx & 7;
            float av[8];
            av[0] = cbv[0].x; av[1] = cbv[0].y; av[2] = cbv[0].z; av[3] = cbv[0].w; av[4] = cbv[1].x; av[5] = cbv[1].y; av[6] = cbv[1].z; av[7] = cbv[1].w;
#pragma unroll
            for (int jj = 0; jj < 4; ++jj) { float r[8]; unpack8(rawl[it][jj], r);
                    const f32x4 w0 = cwv[jj][0], w1 = cwv[jj][1];
                    av[0] += w0.x * r[0]; av[1] += w0.y * r[1]; av[2] += w0.z * r[2]; av[3] += w0.w * r[3]; av[4] += w1.x * r[4]; av[5] += w1.y * r[5]; av[6] += w1.z * r[6]; av[7] += w1.w * r[7]; }
            *(LAS u32x4*)(XC + (k * 72 + cgp * 8) * 2) = pack8(av);
        }
        if (i + 1 < ntile) LRU_ISSUE(i + 1);
        LDS_BARRIER();
        {
            bf16x8 xf[2];
#pragma unroll
            for (int kk = 0; kk < 2; ++kk) xf[kk] = lds_frag(XC + ((16 * wq + l15) * 72 + 32 * kk + lq * 8) * 2);
#pragma unroll
            for (int ni = 0; ni < 4; ++ni) { f32x4 ra = {0.f, 0.f, 0.f, 0.f}, ri = ra;
#pragma unroll
                for (int kk = 0; kk < 2; ++kk) { ra = MFMA16(xf[kk], lds_frag(WA + ((16 * ni + l15) * 72 + 32 * kk + lq * 8) * 2), ra);
                                                 ri = MFMA16(xf[kk], lds_frag(WX + ((16 * ni + l15) * 72 + 32 * kk + lq * 8) * 2), ri); }
#pragma unroll
                for (int jj = 0; jj < 4; ++jj) { const int tok = 16 * wq + 4 * lq + jj, ch = 16 * ni + l15;
                    const float r = __builtin_amdgcn_rcpf(1.f + __expf(-(ra[jj] + bav[ni]))), ig = __builtin_amdgcn_rcpf(1.f + __expf(-(ri[jj] + bxv[ni])));
                    const float log_a = spl[ni] * r; const float a = __expf(log_a);
                    const float xc = bf2f(*(const LAS unsigned short*)(XC + (tok * 72 + ch) * 2));
                    const float uu = __builtin_amdgcn_sqrtf(fmaxf(1.f - a * a, 0.f)) * (ig * xc);
                    As[tok * 65 + ch] = a; Us[tok * 65 + ch] = uu; }
            }
        }
        LDS_BARRIER();
        if (tg < 64) {
#pragma unroll 8
            for (int s = 0; s < 64; ++s) { const int tok = dir == 0 ? s : 63 - s;
                hst = As[tok * 65 + tg] * hst + Us[tok * 65 + tg];
                Us[tok * 65 + tg] = hst; }
        }
        LDS_BARRIER();
#pragma unroll
        for (int it = 0; it < 2; ++it) { const int idx = it * 256 + tg, tok = idx >> 3, c8 = idx & 7; float o[8];
#pragma unroll
            for (int e = 0; e < 8; ++e) o[e] = Us[tok * 65 + c8 * 8 + e];
            *(u32x4*)(Y + (size_t)(tb + tok) * D + kb * 64 + c8 * 8) = pack8(o); }
    }
#undef LRU_ISSUE
    if (!sample && tg < 64) (dir == 0 ? out_f : out_b)[(size_t)(bidx * 2 + jo) * 1024 + kb * 64 + tg] = hst;
}

__device__ __forceinline__ void attn_unit(LAS unsigned char* lds, const bf16_t* P1, const bf16_t* cacheK, const bf16_t* cacheV, int seqrow0, int nkc, int nkn, int qrow, int h,
                                          const float* lp, float lam_init, const float* sub_g, bf16_t* A2) {
    const int tid = opaque_tid(), wave = __builtin_amdgcn_readfirstlane(tid >> 6), lane = tid & 63, comp = wave >> 2, wq = wave & 3, l15 = lane & 15, lq = lane >> 4;
    LAS unsigned char* Ks = lds; LAS unsigned char* VT = lds + 17408; LAS unsigned char* Pw = lds + 35840 + wave * 4608; LAS float* O1 = (LAS float*)(lds + 73728);
    bf16x8 qf[2][2];
    {
        const bf16_t* qb = P1 + (size_t)(qrow + 32 * wq) * NIN_E + COL_Q + h * 128 + comp * 64;
#pragma unroll
        for (int mi = 0; mi < 2; ++mi)
#pragma unroll
            for (int kk = 0; kk < 2; ++kk) qf[mi][kk] = *(const bf16x8*)(qb + (size_t)(16 * mi + l15) * NIN_E + 32 * kk + lq * 8);
    }
    float m_run[2] = {-1e30f, -1e30f}, l_run[2] = {0.f, 0.f};
    f32x4 oT[2][8];
#pragma unroll
    for (int mi = 0; mi < 2; ++mi)
#pragma unroll
        for (int ei = 0; ei < 8; ++ei) oT[mi][ei] = (f32x4){0.f, 0.f, 0.f, 0.f};
    const int ntile = (nkc + nkn) >> 6;
    const int sk = tid >> 3, sc0 = (tid & 7) * 16;
    const int vkey = tid & 63, vc0 = (tid >> 6) * 16, vpos = (vkey & 32) | ((vkey & 12) << 1) | ((vkey & 16) >> 2) | (vkey & 3);
    u32x4 pk0, pk1, pv0, pv1;
#define ATT_PREFETCH(T) do { const int key0_ = (T) * 64; \
        const bf16_t* kp_ = key0_ < nkc ? cacheK + (size_t)(key0_ + sk) * 1024 + h * 128 + sc0 : P1 + (size_t)(seqrow0 + key0_ - nkc + sk) * NIN_E + COL_K + h * 128 + sc0; \
        const bf16_t* vp_ = key0_ < nkc ? cacheV + (size_t)(key0_ + vkey) * 1024 + h * 128 + vc0 : P1 + (size_t)(seqrow0 + key0_ - nkc + vkey) * NIN_E + COL_V + h * 128 + vc0; \
        pk0 = *(const u32x4*)kp_; pk1 = *(const u32x4*)(kp_ + 8); pv0 = *(const u32x4*)vp_; pv1 = *(const u32x4*)(vp_ + 8); } while (0)
    ATT_PREFETCH(0);
    for (int tile = 0; tile < ntile; ++tile) {
        LDS_BARRIER();
        {
            *(LAS u32x4*)(Ks + (sk * 136 + sc0) * 2) = pk0; *(LAS u32x4*)(Ks + (sk * 136 + sc0 + 8) * 2) = pk1;
            const unsigned vw[8] = {pv0.x, pv0.y, pv0.z, pv0.w, pv1.x, pv1.y, pv1.z, pv1.w};
#pragma unroll
            for (int e = 0; e < 8; ++e) { *(LAS unsigned short*)(VT + ((vc0 + 2 * e) * 72 + vpos) * 2) = (unsigned short)(vw[e] & 0xffffu); *(LAS unsigned short*)(VT + ((vc0 + 2 * e + 1) * 72 + vpos) * 2) = (unsigned short)(vw[e] >> 16); }
        }
        LDS_BARRIER();
        if (tile + 1 < ntile) ATT_PREFETCH(tile + 1);
        f32x4 st[2][4];
#pragma unroll
        for (int ni = 0; ni < 4; ++ni) {
            bf16x8 kf[2];
#pragma unroll
            for (int kk = 0; kk < 2; ++kk) kf[kk] = lds_frag(Ks + ((16 * ni + l15) * 136 + comp * 64 + 32 * kk + lq * 8) * 2);
#pragma unroll
            for (int mi = 0; mi < 2; ++mi) { f32x4 s = {0.f, 0.f, 0.f, 0.f};
#pragma unroll
                for (int kk = 0; kk < 2; ++kk) s = MFMA16(kf[kk], qf[mi][kk], s);
                st[mi][ni] = s; }
        }
        float mnew[2]; bool changed = false;
#pragma unroll
        for (int mi = 0; mi < 2; ++mi) {
            float mx = -1e30f;
#pragma unroll
            for (int ni = 0; ni < 4; ++ni)
#pragma unroll
                for (int jj = 0; jj < 4; ++jj) mx = fmaxf(mx, st[mi][ni][jj]);
            mx = x16_max(mx); mx = x32_max(mx);
            mnew[mi] = mx > m_run[mi] + 8.f ? mx : m_run[mi];
            changed = changed || (mnew[mi] != m_run[mi]);
        }
        if (__builtin_amdgcn_ballot_w64(changed) != 0ull) {
#pragma unroll
            for (int mi = 0; mi < 2; ++mi) { const float alpha = __builtin_amdgcn_exp2f(m_run[mi] - mnew[mi]); m_run[mi] = mnew[mi]; l_run[mi] *= alpha;
#pragma unroll
                for (int ei = 0; ei < 8; ++ei) oT[mi][ei] = oT[mi][ei] * alpha; }
        }
        unsigned pp[2][4][2];
#pragma unroll
        for (int mi = 0; mi < 2; ++mi) {
            float ls = 0.f;
#pragma unroll
            for (int ni = 0; ni < 4; ++ni) { float pv[4];
#pragma unroll
                for (int jj = 0; jj < 4; ++jj) { pv[jj] = __builtin_amdgcn_exp2f(st[mi][ni][jj] - m_run[mi]); ls += pv[jj]; }
                pp[mi][ni][0] = cvt_pk_bf16(pv[0], pv[1]); pp[mi][ni][1] = cvt_pk_bf16(pv[2], pv[3]); }
            l_run[mi] += ls;
        }
#pragma unroll
        for (int kk = 0; kk < 2; ++kk) {
            bf16x8 pa[2];
#pragma unroll
            for (int mi = 0; mi < 2; ++mi) pa[mi] = __builtin_bit_cast(bf16x8, (u32x4){pp[mi][2 * kk][0], pp[mi][2 * kk][1], pp[mi][2 * kk + 1][0], pp[mi][2 * kk + 1][1]});
#pragma unroll
            for (int ei = 0; ei < 8; ++ei) { const bf16x8 vb = lds_frag(VT + ((16 * ei + l15) * 72 + 32 * kk + lq * 8) * 2);
#pragma unroll
                for (int mi = 0; mi < 2; ++mi) oT[mi][ei] = MFMA16(vb, pa[mi], oT[mi][ei]); }
        }
        CBAR();
    }
#pragma unroll
    for (int mi = 0; mi < 2; ++mi) { float l = l_run[mi]; l = x16_sum(l); l = x32_sum(l); const float inv = 1.f / l;
#pragma unroll
        for (int ei = 0; ei < 8; ++ei) oT[mi][ei] = oT[mi][ei] * inv; }
#undef ATT_PREFETCH
    const float lam = __expf(wave_sum(lp[lane] * lp[64 + lane], lane)) - __expf(wave_sum(lp[128 + lane] * lp[192 + lane], lane)) + lam_init;
    const float oscale = 1.f - lam_init;
    if (comp == 1) {
#pragma unroll
        for (int mi = 0; mi < 2; ++mi)
#pragma unroll
            for (int ei = 0; ei < 8; ++ei) *(LAS f32x4*)(O1 + (32 * wq + 16 * mi + l15) * 132 + 16 * ei + 4 * lq) = oT[mi][ei];
    }
    __syncthreads();
    if (comp == 0) {
#pragma unroll
        for (int mi = 0; mi < 2; ++mi) { float ss = 0.f;
#pragma unroll
            for (int ei = 0; ei < 8; ++ei) { const f32x4 o1 = *(const LAS f32x4*)(O1 + (32 * wq + 16 * mi + l15) * 132 + 16 * ei + 4 * lq); const f32x4 o = oT[mi][ei] - o1 * lam; oT[mi][ei] = o;
                ss += (o.x * o.x + o.y * o.y) + (o.z * o.z + o.w * o.w); }
            ss = x16_sum(ss); ss = x32_sum(ss);
            const float rstd = rsqrtf(ss * (1.f / 128.f) + EPS) * oscale;
            bf16_t* op = A2 + (size_t)(qrow + 32 * wq + 16 * mi + l15) * 2048 + 1024 + h * 128 + 4 * lq;
#pragma unroll
            for (int ei = 0; ei < 8; ++ei) { const f32x4 gsub = *(const f32x4*)(sub_g + 16 * ei + 4 * lq); const f32x4 o = oT[mi][ei] * rstd * gsub;
                u32x2 w; w.x = cvt_pk_bf16(o.x, o.y); w.y = cvt_pk_bf16(o.z, o.w); *(u32x2*)(op + 16 * ei) = w; }
        }
    }
}

__device__ __forceinline__ int opaque_idx(int i) { asm volatile("" : "+s"(i)); return i; }
__device__ __forceinline__ GAS unsigned char* opaque_ptr(GAS unsigned char* q) { asm volatile("" : "+s"(q)); return q; }
#define x_prompt ((const float*)p.in[opaque_idx(0)])
#define x_sample ((const float*)p.in[opaque_idx(1)])
#define cvec ((const float*)p.in[opaque_idx(2)])
#define cache_k ((const float*)p.in[opaque_idx(3)])
#define cache_v ((const float*)p.in[opaque_idx(4)])
#define st_ssd_f ((const float*)p.in[opaque_idx(5)])
#define st_ssd_b ((const float*)p.in[opaque_idx(6)])
#define st_lru_f ((const float*)p.in[opaque_idx(7)])
#define st_lru_b ((const float*)p.in[opaque_idx(8)])
#define c_ctx ((const float*)p.in[opaque_idx(9)])
#define w_mod ((const float*)p.in[opaque_idx(10)])
#define b_mod ((const float*)p.in[opaque_idx(11)])
#define norm_mix_g ((const float*)p.in[opaque_idx(12)])
#define norm_ffn_g ((const float*)p.in[opaque_idx(13)])
#define w_in_e ((const float*)p.in[opaque_idx(14)])
#define ssd_conv_w ((const float*)p.in[opaque_idx(15)])
#define ssd_conv_b ((const float*)p.in[opaque_idx(16)])
#define ssd_a_log ((const float*)p.in[opaque_idx(17)])
#define ssd_dt_bias ((const float*)p.in[opaque_idx(18)])
#define ssd_d ((const float*)p.in[opaque_idx(19)])
#define ssd_norm_g ((const float*)p.in[opaque_idx(20)])
#define diff_lambda ((const float*)p.in[opaque_idx(21)])
#define diff_norm_g ((const float*)p.in[opaque_idx(22)])
#define w_out_e ((const float*)p.in[opaque_idx(23)])
#define lru_w_in ((const float*)p.in[opaque_idx(24)])
#define lru_conv_w ((const float*)p.in[opaque_idx(25)])
#define lru_conv_b ((const float*)p.in[opaque_idx(26)])
#define lru_wa ((const float*)p.in[opaque_idx(27)])
#define lru_ba ((const float*)p.in[opaque_idx(28)])
#define lru_wx ((const float*)p.in[opaque_idx(29)])
#define lru_bx ((const float*)p.in[opaque_idx(30)])
#define lru_lambda ((const float*)p.in[opaque_idx(31)])
#define lru_w_out ((const float*)p.in[opaque_idx(32)])
#define ffn_w_up ((const float*)p.in[opaque_idx(33)])
#define ffn_conv_w ((const float*)p.in[opaque_idx(34)])
#define ffn_conv_b ((const float*)p.in[opaque_idx(35)])
#define ffn_w_down ((const float*)p.in[opaque_idx(36)])
#define final_norm_g ((const float*)p.in[opaque_idx(37)])
#define WSB ((unsigned char*)opaque_ptr(p.ws))
#define OUTB ((float*)opaque_ptr((GAS unsigned char*)p.out))
#define X OUTB
#define outK (OUTB + 16777216)
#define outV (OUTB + 2 * 16777216)
#define outSF (OUTB + 3 * 16777216)
#define outSB (OUTB + 3 * 16777216 + 4194304)
#define outLF (OUTB + 3 * 16777216 + 2 * 4194304)
#define outLB (OUTB + 3 * 16777216 + 2 * 4194304 + 65536)
#define ROPE ((float*)(WSB + WS_ROPE))
#define MOD ((float*)(WSB + WS_MOD))
#define LRUW ((bf16_t*)(WSB + WS_LRUW))
#define DTB ((float*)(WSB + WS_DT))
#define WIN_E ((bf16_t*)(WSB + WS_WIN_E))
#define WOUT_E ((bf16_t*)(WSB + WS_WOUT_E))
#define WIN_O ((bf16_t*)(WSB + WS_WIN_O))
#define WOUT_O ((bf16_t*)(WSB + WS_WOUT_O))
#define WUP ((bf16_t*)(WSB + WS_WUP))
#define WDN ((bf16_t*)(WSB + WS_WDN))
#define HBF ((bf16_t*)(WSB + WS_HBF))
#define YF ((bf16_t*)(WSB + WS_YF))
#define YB ((bf16_t*)(WSB + WS_YB))
#define P1 ((bf16_t*)(WSB + WS_P1))
#define A2 ((bf16_t*)(WSB + WS_A2))
#define SBB ((float*)(WSB + WS_SB))
#define PARTB ((float*)(WSB + WS_PART))
#define KCB ((bf16_t*)(WSB + WS_A2 + 64 * MiB))
__global__ void __launch_bounds__(512, 2) mega_fwd(Params p) {
    extern __shared__ __attribute__((aligned(16))) unsigned char lds_raw[];
    LAS unsigned char* lds = (LAS unsigned char*)lds_raw;
    cg::grid_group grid = cg::this_grid();
    { volatile LAS unsigned* st_ = (volatile LAS unsigned*)(lds + LDS_BYTES - 16); if (threadIdx.x < 2) st_[threadIdx.x] = 0u; }
    __syncthreads();
    (void)xcd_barrier_post((unsigned*)((unsigned char*)p.ws + WS_BAR), (volatile LAS unsigned*)(lds + LDS_BYTES - 16));
    const int G = gridDim.x, bx = blockIdx.x;
    const int vbx = (G % 8 == 0) ? (bx % 8) * (G / 8) + bx / 8 : bx;
    for (int rep = 0; rep < REP_P0; ++rep) {
        __syncthreads();
        const int tid = opaque_tid(), lane = tid & 63, wave = __builtin_amdgcn_readfirstlane(tid >> 6);
        const int gw = bx * 8 + wave, NGW = G * 8, gtid = bx * 512 + tid, nthreads = G * 512;
        LAS float* scr = (LAS float*)(lds + wave * 16384);
        constexpr int I_WIN_E = 16 * 169, I_WOUT_E = 32 * 32, I_WIN_O = 16 * 64, I_WOUT_O = 16 * 32, I_WUP = 16 * 176, I_WDN = 44 * 32;
        constexpr int NITEMS = 2 * I_WIN_E + 2 * I_WOUT_E + 2 * I_WIN_O + 2 * I_WOUT_O + 4 * I_WUP + 4 * I_WDN;
        for (int it = gw; it < NITEMS; it += NGW) {
            int r = it;
            if (r < 2 * I_WIN_E) { const int j = r / I_WIN_E; transpose_item(w_in_e + (size_t)j * 1024 * 5408, 1024, 5408, WIN_E + (size_t)j * NIN_E * 1024, 2336, 224, scr, r % I_WIN_E, lane); continue; } r -= 2 * I_WIN_E;
            if (r < 2 * I_WOUT_E) { const int j = r / I_WOUT_E; transpose_item(w_out_e + (size_t)j * 2048 * 1024, 2048, 1024, WOUT_E + (size_t)j * 1024 * 2048, 1 << 30, 0, scr, r % I_WOUT_E, lane); continue; } r -= 2 * I_WOUT_E;
            if (r < 2 * I_WIN_O) { const int j = r / I_WIN_O; transpose_item(lru_w_in + (size_t)j * 1024 * 2048, 1024, 2048, WIN_O + (size_t)j * 2048 * 1024, 1 << 30, 0, scr, r % I_WIN_O, lane); continue; } r -= 2 * I_WIN_O;
            if (r < 2 * I_WOUT_O) { const int j = r / I_WOUT_O; transpose_item(lru_w_out + (size_t)j * 1024 * 1024, 1024, 1024, WOUT_O + (size_t)j * 1024 * 1024, 1 << 30, 0, scr, r % I_WOUT_O, lane); continue; } r -= 2 * I_WOUT_O;
            if (r < 4 * I_WUP) { const int l = r / I_WUP; transpose_item(ffn_w_up + (size_t)l * 1024 * 5632, 1024, 5632, WUP + (size_t)l * 5632 * 1024, -1, 0, scr, r % I_WUP, lane); continue; } r -= 4 * I_WUP;
            { const int l = r / I_WDN; transpose_item(ffn_w_down + (size_t)l * 2816 * 1024, 2816, 1024, WDN + (size_t)l * 1024 * 2816, 1 << 30, 0, scr, r % I_WDN, lane); }
        }
        for (int i = gtid; i < 2 * 224 * 128; i += nthreads) { const int j = i / (224 * 128), r = (i / 128) % 224, cc = i % 128;
            *(u32x4*)(WIN_E + ((size_t)j * NIN_E + 2336 + r) * 1024 + cc * 8) = (u32x4){0u, 0u, 0u, 0u}; }
        for (int i = gtid; i < 524288; i += nthreads) { const int k = i & 63, jj = (i >> 6) & 63, blk = (i >> 12) & 15, which = (i >> 16) & 1, ld = i >> 17;
            const float* src = which == 0 ? lru_wa : lru_wx; LRUW[i] = f2bf(src[((size_t)ld * 16 + blk) * 4096 + k * 64 + jj]); }
        if (bx == 0) { for (int i = tid; i < 1024; i += 512) { const int pos = i >> 4, fi = i & 15; const float fr = powf(10000.f, -(float)(2 * fi) / 32.f); const float ang = (float)pos * fr;
            ROPE[i] = cosf(ang); ROPE[1024 + i] = sinf(ang); } }
        __syncthreads();
        LAS float* sv = (LAS float*)lds;
        LAS float* red = (LAS float*)(lds + 36864);
        bool sv_ready = false;
        for (int unit = bx; unit < 4 * 96; unit += G) {
            if (!sv_ready) { for (int i = tid; i < 9 * 1024; i += 512) { const int ci = i >> 10, k = i & 1023; const float cvv = ci == 0 ? c_ctx[k] : cvec[(ci - 1) * 1024 + k]; sv[i] = siluf_(cvv); } sv_ready = true; }
            __syncthreads();
            const int l = unit / 96, nb = unit % 96, col = nb * 64 + lane;
            float acc9[9];
#pragma unroll
            for (int ci = 0; ci < 9; ++ci) acc9[ci] = 0.f;
            const float* wp = w_mod + ((size_t)l * 1024 + wave * 128) * 6144 + col;
#pragma unroll 4
            for (int k4 = 0; k4 < 32; ++k4) {
                const float w0 = wp[(size_t)(4 * k4) * 6144], w1 = wp[(size_t)(4 * k4 + 1) * 6144], w2 = wp[(size_t)(4 * k4 + 2) * 6144], w3 = wp[(size_t)(4 * k4 + 3) * 6144];
#pragma unroll
                for (int ci = 0; ci < 9; ++ci) { const f32x4 s4 = *(const LAS f32x4*)(sv + ci * 1024 + wave * 128 + 4 * k4); acc9[ci] += (s4.x * w0 + s4.y * w1) + (s4.z * w2 + s4.w * w3); }
            }
#pragma unroll
            for (int ci = 0; ci < 9; ++ci) red[(wave * 9 + ci) * 64 + lane] = acc9[ci];
            __syncthreads();
            for (int e = tid; e < 576; e += 512) { const int ci = e >> 6, ln = e & 63; float s = 0.f;
#pragma unroll
                for (int w = 0; w < 8; ++w) s += red[(w * 9 + ci) * 64 + ln];
                MOD[((size_t)l * 9 + ci) * 6144 + nb * 64 + ln] = s + b_mod[l * 6144 + nb * 64 + ln]; }
        }
    }
    CG_SYNC();
    first_rows(x_prompt, x_sample, X, norm_mix_g, MOD, HBF, PARTB);
    cache_to_bf16(cache_k, cache_v, 0, KCB);
    for (int jj = 0; jj < 2; ++jj) { sb_gemv_phase(MOD, WIN_E + (size_t)jj * NIN_E * 1024, NIN_E, 2 * jj, 0, SBB + (size_t)jj * 9 * NIN_E, NIN_E);
                                     sb_gemv_phase(MOD, WIN_O + (size_t)jj * 2048 * 1024, 2048, 2 * jj + 1, 0, SBB + 101376 + (size_t)jj * 18432, 2048); }
    for (int ll = 0; ll < 4; ++ll) sb_gemv_phase(MOD, WUP + (size_t)ll * NFF2 * 1024, NFF2, ll, 3, SBB + 138240 + (size_t)ll * 50688, NFF2);
    GRID_SYNC();

    for (int l = 0; l < 4; ++l) {
        const int j = l >> 1;
#define mod_l (MOD + (size_t)l * 9 * 6144)
        if ((l & 1) == 0) {
            {
                pg8::Gemm g{HBF, WIN_E + (size_t)j * NIN_E * 1024, NTOK, NIN_E, 1024}; pg8::StaticOrder S; S.init(NTOK, NIN_E, G, bx);
                if (l == 2) cache_to_bf16(cache_k, cache_v, 1, KCB);
                EpiInEven E{P1, DTB, outK, outV, ROPE, j, PARTB, SBB + (size_t)j * 9 * NIN_E};
                for (int rep = 0; rep < REP_GP; ++rep) pg8::gemm_phase<EpiInEven, pg8::StaticOrder, true, true>(lds, g, S, E);
            }
            GRID_SYNC();
            if (STOP_AT == 1) return;
            {
                for (int rep = 0; rep < REP_SSD; ++rep)
                for (int bun = vbx; bun < 256; bun += G) {
                    if (!EN_SSD) break;
                    if (bun < 128) { const int b = bun >> 4, h = bun & 15;
                        ssd_unit(lds, P1, DTB, NPROMPT + b * 1024, 1024, b, true, h, j, ssd_conv_w, ssd_conv_b, ssd_a_log, ssd_dt_bias, ssd_d, st_ssd_f, st_ssd_b, outSF, outSB, YF, YB);
                    } else { for (int q4 = 0; q4 < 4; ++q4) { const int u = (bun - 128) * 4 + q4, b = u >> 4, h = u & 15;
                        ssd_unit(lds, P1, DTB, b * 256, 256, b, false, h, j, ssd_conv_w, ssd_conv_b, ssd_a_log, ssd_dt_bias, ssd_d, st_ssd_f, st_ssd_b, outSF, outSB, YF, YB); } }
                }
                __syncthreads();
                const float lam_init = (l == 0) ? 0.2f : 0.47071302f;
                for (int rep = 0; rep < REP_ATTN; ++rep)
                for (int bun = vbx; bun < 256; bun += G) {
                    if (!EN_ATTN) break;
                    for (int q2 = 0; q2 < 2; ++q2) { const int u = bun * 2 + q2, qb = u & 7, h = (u >> 3) & 7, b = u >> 6;
                        attn_unit(lds, P1, KCB + (size_t)b * 524288, KCB + 4194304 + (size_t)b * 524288, NPROMPT + b * 1024, 512, 1024, NPROMPT + b * 1024 + qb * 128, h, diff_lambda + j * 256, lam_init, diff_norm_g + j * 128, A2); }
                    for (int q2 = 0; q2 < 2; ++q2) { const int u = bun * 2 + q2, qb = u & 1, h = (u >> 1) & 7, b = u >> 4;
                        attn_unit(lds, P1, nullptr, nullptr, b * 256, 0, 256, b * 256 + qb * 128, h, diff_lambda + j * 256, lam_init, diff_norm_g + j * 128, A2); }
                }
            }
            GRID_SYNC();
            if (STOP_AT == 2) return;
            for (int rep = 0; rep < REP_ELT; ++rep) ssd_gate_phase(YF, YB, P1, ssd_norm_g + j * 1024, A2);
            GRID_SYNC();
            {
                pg8::Gemm g{A2, WOUT_E + (size_t)j * 1024 * 2048, NTOK, 1024, 2048}; pg8::StaticOrder S; S.init(NTOK, 1024, G, bx);
                EpiResid E{X, mod_l + 2 * 1024, HBF, norm_ffn_g + l * 1024, mod_l + 4 * 1024, PARTB + 262144, l == 0 ? x_prompt : (const float*)X, l == 0 ? x_sample : (const float*)X + (size_t)NPROMPT * 1024};
                pg8::gemm_phase<EpiResid, pg8::StaticOrder, false, true>(lds, g, S, E);
            }
            GRID_SYNC();
        } else {
            {
                pg8::Gemm g{HBF, WIN_O + (size_t)j * 2048 * 1024, NTOK, 2048, 1024}; pg8::StaticOrder S; S.init(NTOK, 2048, G, bx);
                EpiScaledBf16 E{P1, 2048, PARTB, SBB + 101376 + (size_t)j * 18432};
                for (int rep = 0; rep < REP_GP; ++rep) pg8::gemm_phase<EpiScaledBf16, pg8::StaticOrder, true, true>(lds, g, S, E);
            }
            GRID_SYNC();
            for (int rep = 0; rep < REP_LRU; ++rep)
            for (int bun = vbx; bun < 256; bun += G) {
                if (!EN_LRU) break;
                if (bun < 128) { const int b = bun >> 4, kb = bun & 15;
                    lru_unit(lds, P1, NPROMPT + b * 1024, 1024, b, true, kb, j, LRUW, lru_conv_w, lru_conv_b, lru_ba, lru_bx, lru_lambda, st_lru_f, st_lru_b, outLF, outLB, YF, YB);
                } else { for (int q4 = 0; q4 < 4; ++q4) { const int u = (bun - 128) * 4 + q4, b = u >> 4, kb = u & 15;
                    lru_unit(lds, P1, b * 256, 256, b, false, kb, j, LRUW, lru_conv_w, lru_conv_b, lru_ba, lru_bx, lru_lambda, st_lru_f, st_lru_b, outLF, outLB, YF, YB); } }
            }
            GRID_SYNC();
            for (int rep = 0; rep < REP_ELT; ++rep) lru_gate_phase(YF, YB, P1, A2);
            GRID_SYNC();
            {
                pg8::Gemm g{A2, WOUT_O + (size_t)j * 1024 * 1024, NTOK, 1024, 1024}; pg8::StaticOrder S; S.init(NTOK, 1024, G, bx);
                EpiResid E{X, mod_l + 2 * 1024, HBF, norm_ffn_g + l * 1024, mod_l + 4 * 1024, PARTB + 262144, l == 0 ? x_prompt : (const float*)X, l == 0 ? x_sample : (const float*)X + (size_t)NPROMPT * 1024};
                pg8::gemm_phase<EpiResid, pg8::StaticOrder, false, true>(lds, g, S, E);
            }
            GRID_SYNC();
        }
        if (STOP_AT == 3) return;
        {
            pg8::Gemm g{HBF, WUP + (size_t)l * NFF2 * 1024, NTOK, NFF2, 1024}; pg8::StaticOrder S; S.init(NTOK, NFF2, G, bx);
#if FFN_FUSED
            EpiFfnAct E{A2, PARTB + 262144, SBB + 138240 + (size_t)l * 50688, ffn_conv_w + (size_t)l * 3 * NFF2, ffn_conv_b + (size_t)l * NFF2, P1, lds + 131072};
            pg8::gemm_phase<EpiFfnAct, pg8::StaticOrder, true, true>(lds, g, S, E);
#else
            EpiScaledBf16 E{P1, NFF2, PARTB + 262144, SBB + 138240 + (size_t)l * 50688};
            for (int rep = 0; rep < REP_GP; ++rep) pg8::gemm_phase<EpiScaledBf16, pg8::StaticOrder, true, true>(lds, g, S, E);
#endif
        }
        GRID_SYNC();
#if !FFN_FUSED
        for (int rep = 0; rep < REP_ELT; ++rep) ffn_act_phase(P1, ffn_conv_w + (size_t)l * 3 * NFF2, ffn_conv_b + (size_t)l * NFF2, A2);
        GRID_SYNC();
#endif
        {
            pg8::Gemm g{A2, WDN + (size_t)l * 1024 * NFF, NTOK, 1024, NFF}; pg8::StaticOrder S; S.init(NTOK, 1024, G, bx);
#if FFN_FUSED
            for (int ui = 0; ; ++ui) { pg8::Unit uu; if (!S.next(ui, uu)) break; ffn_fix_panel(P1, ffn_conv_w + (size_t)l * 3 * NFF2, ffn_conv_b + (size_t)l * NFF2, A2, uu.pm); }
            asm volatile("s_waitcnt vmcnt(0)" ::: "memory"); __syncthreads();
#endif
            EpiResid E{X, mod_l + 5 * 1024, l < 3 ? HBF : nullptr, norm_mix_g + (size_t)(l < 3 ? l + 1 : l) * 1024, MOD + (size_t)(l < 3 ? l + 1 : l) * 9 * 6144 + 1024, PARTB, (const float*)X, (const float*)X + (size_t)NPROMPT * 1024};
            pg8::gemm_phase<EpiResid, pg8::StaticOrder, false, true>(lds, g, S, E);
        }
        GRID_SYNC();
        if (STOP_AT == 4) return;
    }
    norm_rows<1, false>(nullptr, nullptr, X, final_norm_g, nullptr, 0, nullptr);
}

extern "C" void kernel_launch(void* const* d_in, const int* in_sizes, int n_in, void* d_out, int out_size, void* d_ws, size_t ws_size, hipStream_t stream) {
    static int grid_blocks = 0;
    if (grid_blocks == 0) {
        if (n_in != 38 || ws_size < WS_END) { fprintf(stderr, "kernel_launch: unexpected n_in %d / ws_size %zu\n", n_in, ws_size); grid_blocks = -1; return; }
        int dev = 0, cus = 0, per_cu = 0;
        hipGetDevice(&dev);
        hipDeviceGetAttribute(&cus, hipDeviceAttributeMultiprocessorCount, dev);
        hipFuncSetAttribute((const void*)mega_fwd, hipFuncAttributeMaxDynamicSharedMemorySize, LDS_BYTES);
        hipOccupancyMaxActiveBlocksPerMultiprocessor(&per_cu, (const void*)mega_fwd, 512, LDS_BYTES);
        if (per_cu < 1) { fprintf(stderr, "kernel_launch: occupancy query says %d blocks per CU\n", per_cu); per_cu = 1; }
        if (per_cu > 1) per_cu = 1;
        grid_blocks = cus * per_cu;
        (void)hipGetLastError();
    }
    if (grid_blocks < 0) return;
    (void)hipMemsetAsync((unsigned char*)d_ws + WS_BAR, 0, 16384, stream);
    Params p{};
    for (int i = 0; i < 38; ++i) p.in[i] = (gcfp)d_in[i];
    p.out = (GAS float*)d_out; p.ws = (GAS unsigned char*)d_ws;
    void* args[] = {&p};
    hipError_t e = hipLaunchCooperativeKernel((const void*)mega_fwd, dim3(grid_blocks), dim3(512), args, LDS_BYTES, stream);
    if (e != hipSuccess) fprintf(stderr, "cooperative launch failed: %s (grid %d)\n", hipGetErrorString(e), grid_blocks);
}
```

```cpp
#include <hip/hip_runtime.h>
#include <hip/hip_cooperative_groups.h>
#include <cstdio>
#include <cstdint>
namespace cg = cooperative_groups;
#ifndef EN_G1
#define EN_G1 1
#endif
#ifndef EN_G2
#define EN_G2 1
#endif
#ifndef EN_G3
#define EN_G3 1
#endif
#ifndef REP_SSD
#define REP_SSD 1
#endif
#ifndef REP_ATTN
#define REP_ATTN 1
#endif
#ifndef REP_LRU
#define REP_LRU 1
#endif
#ifndef REP_ELT
#define REP_ELT 1
#endif
#ifndef REP_GP
#define REP_GP 1
#endif
#ifndef REP_P0
#define REP_P0 1
#endif
#ifndef REP_SYNC
#define REP_SYNC 1
#endif
#ifndef FFN_FUSED
#define FFN_FUSED 1
#endif
#ifndef STOP_AT
#define STOP_AT 0
#endif
#ifndef EN_SSD
#define EN_SSD 1
#endif
#ifndef EN_ATTN
#define EN_ATTN 1
#endif
#ifndef EN_LRU
#define EN_LRU 1
#endif
#ifndef EN_GEMM
#define EN_GEMM 1
#endif
#ifndef EN_P0
#define EN_P0 1
#endif
#ifndef EN_ELT
#define EN_ELT 1
#endif

#define LAS __attribute__((address_space(3)))
typedef unsigned short bf16_t;
typedef short bf16x8 __attribute__((ext_vector_type(8)));
typedef float f32x4 __attribute__((ext_vector_type(4)));
typedef float f32x2 __attribute__((ext_vector_type(2)));
typedef unsigned u32x4 __attribute__((ext_vector_type(4)));
typedef unsigned u32x2 __attribute__((ext_vector_type(2)));

constexpr int D = 1024, NTOK = 16384, NPROMPT = 8192;
constexpr int NIN_E = 5632;
constexpr int COL_XBC = 1024, COL_DT = 2304, COL_Q = 2560, COL_K = 3584, COL_V = 4608;
constexpr int NFF2 = 5632, NFF = 2816;
constexpr float EPS = 1e-6f;
constexpr int LDS_BYTES = 147456;
constexpr float QSCALE = 0.125f * 1.4426950408889634f;

constexpr size_t MiB = 1u << 20;
constexpr size_t WS_ROPE = 0;
constexpr size_t WS_BAR = 65536;
constexpr size_t WS_MOD = 1 * MiB;
constexpr size_t WS_LRUW = 2 * MiB;
constexpr size_t WS_DT = 3 * MiB;
constexpr size_t WS_WIN_E = 5 * MiB;
constexpr size_t WS_WOUT_E = 27 * MiB;
constexpr size_t WS_WIN_O = 35 * MiB;
constexpr size_t WS_WOUT_O = 43 * MiB;
constexpr size_t WS_WUP = 47 * MiB;
constexpr size_t WS_WDN = 91 * MiB;
constexpr size_t WS_HBF = 113 * MiB;
constexpr size_t WS_YF = 113 * MiB;
constexpr size_t WS_YB = 145 * MiB;
constexpr size_t WS_P1 = 177 * MiB;
constexpr size_t WS_A2 = 353 * MiB;
constexpr size_t WS_SB = 441 * MiB;
constexpr size_t WS_PART = 443 * MiB;
constexpr size_t WS_END = 445 * MiB;

typedef __bf16 bf16x2_t __attribute__((ext_vector_type(2)));
__device__ __forceinline__ unsigned cvt_pk_bf16(float lo, float hi) { const f32x2 v = {lo, hi}; const bf16x2_t b = __builtin_convertvector(v, bf16x2_t); return __builtin_bit_cast(unsigned, b); }
__device__ __forceinline__ unsigned short f2bf(float f) { return (unsigned short)(cvt_pk_bf16(f, 0.f) & 0xffffu); }
__device__ __forceinline__ float bflo(unsigned u) { return __uint_as_float(u << 16); }
__device__ __forceinline__ float bfhi(unsigned u) { return __uint_as_float(u & 0xffff0000u); }
__device__ __forceinline__ float bf2f(unsigned short h) { return __uint_as_float(((unsigned)h) << 16); }
__device__ __forceinline__ void unpack8(const u32x4 v, float* o) { o[0] = bflo(v.x); o[1] = bfhi(v.x); o[2] = bflo(v.y); o[3] = bfhi(v.y); o[4] = bflo(v.z); o[5] = bfhi(v.z); o[6] = bflo(v.w); o[7] = bfhi(v.w); }
__device__ __forceinline__ u32x4 pack8(const float* v) { u32x4 w; w.x = cvt_pk_bf16(v[0], v[1]); w.y = cvt_pk_bf16(v[2], v[3]); w.z = cvt_pk_bf16(v[4], v[5]); w.w = cvt_pk_bf16(v[6], v[7]); return w; }
__device__ __forceinline__ float shfl_xor_l(float v, int mask, int lane) { return __int_as_float(__builtin_amdgcn_ds_bpermute((lane ^ mask) << 2, __float_as_int(v))); }
__device__ __forceinline__ float shfl_idx_l(float v, int src) { return __int_as_float(__builtin_amdgcn_ds_bpermute(src << 2, __float_as_int(v))); }
__device__ __forceinline__ float x32_sum(float v) { const auto r = __builtin_amdgcn_permlane32_swap(__float_as_uint(v), __float_as_uint(v), false, false); return __uint_as_float(r[0]) + __uint_as_float(r[1]); }
__device__ __forceinline__ float x16_sum(float v) { const auto r = __builtin_amdgcn_permlane16_swap(__float_as_uint(v), __float_as_uint(v), false, false); return __uint_as_float(r[0]) + __uint_as_float(r[1]); }
__device__ __forceinline__ float x32_max(float v) { const auto r = __builtin_amdgcn_permlane32_swap(__float_as_uint(v), __float_as_uint(v), false, false); return fmaxf(__uint_as_float(r[0]), __uint_as_float(r[1])); }
__device__ __forceinline__ float x16_max(float v) { const auto r = __builtin_amdgcn_permlane16_swap(__float_as_uint(v), __float_as_uint(v), false, false); return fmaxf(__uint_as_float(r[0]), __uint_as_float(r[1])); }
#define DPPF(x, ctrl) __int_as_float(__builtin_amdgcn_update_dpp(0, __float_as_int(x), (ctrl), 0xF, 0xF, false))
__device__ __forceinline__ float wave_sum(float v, int) {
    v += DPPF(v, 0xB1); v += DPPF(v, 0x4E); v += DPPF(v, 0x141); v += DPPF(v, 0x140);
    v = x16_sum(v); v = x32_sum(v);
    return v;
}
__device__ __forceinline__ float sigmoidf_(float x) { return 1.f / (1.f + __expf(-x)); }
__device__ __forceinline__ float siluf_(float x) { return x * __builtin_amdgcn_rcpf(1.f + __expf(-x)); }
__device__ __forceinline__ float softplusf_(float x) { return fmaxf(x, 0.f) + __logf(1.f + __expf(-fabsf(x))); }
__device__ __forceinline__ float gelu_tanh(float x) { const float u = 0.7978845608028654f * (x + 0.044715f * x * x * x); return x * __builtin_amdgcn_rcpf(1.f + __expf(-2.f * u)); }
__device__ __forceinline__ int opaque_tid() { int t = threadIdx.x; asm volatile("" : "+v"(t)); return t; }
#define CG_SYNC() for (int rs_ = 0; rs_ < REP_SYNC; ++rs_) do { asm volatile("s_waitcnt vmcnt(0) lgkmcnt(0)" ::: "memory"); grid.sync(); \
    if (__builtin_amdgcn_readfirstlane(threadIdx.x >> 6) == 0) { __builtin_amdgcn_fence(__ATOMIC_ACQUIRE, "agent"); asm volatile("s_waitcnt vmcnt(0)" ::: "memory"); } \
    __syncthreads(); } while (0)
#define GRID_SYNC() for (int rs_ = 0; rs_ < REP_SYNC; ++rs_) { XcdBarrier xb_; xb_.bar = (unsigned*)(WSB + WS_BAR); xb_.x = xb_xcc_id(); xb_.st = (volatile LAS unsigned*)(lds + LDS_BYTES - 16); xcd_barrier(xb_); }
#define LDS_BARRIER() asm volatile("s_waitcnt lgkmcnt(0)\n\ts_barrier" ::: "memory")
#define CBAR() asm volatile("s_waitcnt lgkmcnt(0)" ::: "memory")
#define MFMA16(a, b, c) __builtin_amdgcn_mfma_f32_16x16x32_bf16((a), (b), (c), 0, 0, 0)
__device__ __forceinline__ bf16x8 lds_frag(const LAS unsigned char* p) { return *(const LAS bf16x8*)p; }


#define XB_TMO      128
#define XB_XCNT(j)  (256  + 64 * (j))
#define XB_XSUB(j)  (1280 + 64 * (j))
#define XB_XGEN(j)  (2304 + 64 * (j))
#define XB_TOP      3328
#define XB_TOPGEN   3392
#define XCD_BAR_WORDS 3456
#define XB_SPIN_CAP (1u << 18)
__device__ __forceinline__ unsigned xb_ld(unsigned* p)              { return __hip_atomic_load(p, __ATOMIC_RELAXED, __HIP_MEMORY_SCOPE_AGENT); }
__device__ __forceinline__ unsigned xb_add(unsigned* p, unsigned v) { return __hip_atomic_fetch_add(p, v, __ATOMIC_RELAXED, __HIP_MEMORY_SCOPE_AGENT); }
__device__ __forceinline__ unsigned xb_xcc_id() { return (unsigned)__builtin_amdgcn_s_getreg((3 << 11) | 20) & 0xFu; }
#define XB_SPIN(cond, bar) do { unsigned _sp = 0; while (cond) { __builtin_amdgcn_s_sleep(1); \
    if ((++_sp & 255u) == 0u) { if (xb_ld(&(bar)[XB_TMO])) break; if (_sp > XB_SPIN_CAP) { atomicAdd(&(bar)[XB_TMO], 1u); break; } } } } while (0)
struct XcdBarrier { unsigned* bar; unsigned x; volatile LAS unsigned* st; };
__device__ __forceinline__ XcdBarrier xcd_barrier_post(unsigned* bar, volatile LAS unsigned* st) {
    XcdBarrier b; b.bar = bar; b.x = xb_xcc_id(); b.st = st;
    if (threadIdx.x == 0) (void)xb_add(&bar[XB_XCNT(b.x)], 1u);
    return b;
}
__device__ __forceinline__ void xcd_barrier_complete(unsigned* bar, unsigned x, unsigned& nloc, unsigned& nx) {
    const unsigned G = gridDim.x * gridDim.y * gridDim.z;
    unsigned sum, cnt, mine, sp = 0u;
    for (;;) {
        sum = 0u; cnt = 0u; mine = 0u;
#pragma unroll
        for (unsigned j = 0; j < 16; ++j) { const unsigned c = xb_ld(&bar[XB_XCNT(j)]); sum += c; cnt += (c > 0u) ? 1u : 0u; mine = (j == x) ? c : mine; }
        if (sum == G) break;
        __builtin_amdgcn_s_sleep(1);
        if ((++sp & 255u) == 0u) { if (xb_ld(&bar[XB_TMO])) break; if (sp > XB_SPIN_CAP) { atomicAdd(&bar[XB_TMO], 1u); break; } }
    }
    nloc = mine > 0u ? mine : 1u; nx = cnt > 0u ? cnt : 1u;
}
__device__ __forceinline__ void xcd_barrier(const XcdBarrier& b) {
    asm volatile("s_waitcnt vmcnt(0)" ::: "memory");
    __syncthreads();
    if (threadIdx.x == 0) {
        unsigned* bar = b.bar;
        __builtin_amdgcn_s_waitcnt(0);
        unsigned nloc = b.st[0], nx = b.st[1];
        if (nloc == 0u) { xcd_barrier_complete(bar, b.x, nloc, nx); b.st[0] = nloc; b.st[1] = nx; }
        const unsigned old = xb_add(&bar[XB_XSUB(b.x)], 1u);
        const unsigned gen = old / nloc;
        if (old + 1u == (gen + 1u) * nloc) {
            __builtin_amdgcn_fence(__ATOMIC_RELEASE, "agent");
            asm volatile("s_waitcnt vmcnt(0)" ::: "memory");
            const unsigned og = xb_add(&bar[XB_TOP], 1u);
            const unsigned tg = og / nx;
            if (og + 1u == (tg + 1u) * nx) xb_add(&bar[XB_TOPGEN], 1u);
            else XB_SPIN(xb_ld(&bar[XB_TOPGEN]) == tg, bar);
            __builtin_amdgcn_fence(__ATOMIC_ACQUIRE, "agent");
            xb_add(&bar[XB_XGEN(b.x)], 1u);
            asm volatile("s_waitcnt vmcnt(0)" ::: "memory");
        } else {
            XB_SPIN(xb_ld(&bar[XB_XGEN(b.x)]) == gen, bar);
            __builtin_amdgcn_fence(__ATOMIC_ACQUIRE, "agent");
            asm volatile("s_waitcnt vmcnt(0)" ::: "memory");
        }
    }
    __syncthreads();
}

namespace pg8 {
#define PG8_LAS __attribute__((address_space(3)))
constexpr int BM = 256, BK = 64, HALF = 128, HTB = HALF * BK * 2, STAGE_BYTES = 8 * HTB, NXCD = 8, WGM = 8;
__host__ __device__ __forceinline__ int lds_byte(int r, int c) { const int st = (r >> 4) * 2 + (c >> 5), rr = r & 15, cc = c & 31, ob = rr * 64 + cc * 2; return st * 1024 + (ob ^ (((ob >> 9) & 1) << 5)); }
__host__ __device__ __forceinline__ void stage_rc(int b, int& R, int& C) { const int st = b / 1024, sb = b % 1024, swz = sb ^ (((sb >> 9) & 1) << 5); R = (st >> 1) * 16 + swz / 64; C = (st & 1) * 32 + (swz % 64) / 2; }
__host__ __device__ __forceinline__ int perm32(int rho) { const int n = rho >> 4, i = rho & 15; return 8 * (i >> 2) + 4 * n + (i & 3); }
struct Unit { int pm, pn; };
struct Gemm { const bf16_t* A; const bf16_t* Bt; int M, N, K; };
struct StaticOrder {
    int nM, nN, nwg, G, c;
    __host__ __device__ void init(int M, int N, int G_, int c_) { nM = M / BM; nN = N / BM; nwg = nM * nN; G = G_; c = c_; }
    __host__ __device__ __forceinline__ bool next(int i, Unit& u) const {
        const long L = (long)i * G + c; if (L >= nwg) return false;
        int wgid = (int)L; { const int q = nwg / NXCD, r = nwg % NXCD, xcd = wgid % NXCD, off = wgid / NXCD; wgid = (xcd < r ? xcd * (q + 1) : r * (q + 1) + (xcd - r) * q) + off; }
        const int nig = WGM * nN, gid = wgid / nig, fm = gid * WGM, gsz = (nM - fm) < WGM ? (nM - fm) : WGM;
        u.pm = fm + ((wgid % nig) % gsz); u.pn = (wgid % nig) / gsz; return true;
    }
    __device__ __forceinline__ void a_ready(const Unit&) const {}
    __device__ __forceinline__ void done(const Unit&) const {}
};
template <class Epi, class Sched, bool ALIGN_EPI = false, bool SP2 = false>
__device__ __forceinline__ void gemm_phase(PG8_LAS unsigned char* lds, const Gemm g, const Sched& S, const Epi& E) {
    const int tid = opaque_tid(), wid = __builtin_amdgcn_readfirstlane(tid >> 6), lane = tid & 63, wr = wid >> 2, wc = wid & 3, fr = lane & 15, fq = lane >> 4;
    const int K = g.K, nt = K / BK;
    unsigned voffA[2], voffB[2];
#pragma unroll
    for (int i = 0; i < 2; ++i) { int R, C; stage_rc(tid * 16 + i * 8192, R, C); const int Rb = Epi::PERM ? ((R & ~31) + perm32(R & 31)) : R;
        voffA[i] = (unsigned)(R * K + C) * 2u; voffB[i] = (unsigned)(Rb * K + C) * 2u; }
    const size_t kstep = (size_t)(BK * 2);
    const size_t hstep = (size_t)HALF * K * 2;
    const size_t tstep = 2 * hstep;
    const unsigned ldsw = (unsigned)wid * 1024u;
    const int aoff = lds_byte(wr * 64 + fr, fq * 8), boff = lds_byte(wc * 32 + fr, fq * 8);
#define PG8_SA(b, h) (((b) * 2 + (h)) * HTB)
#define PG8_SB(b, h) ((4 + (b) * 2 + (h)) * HTB)
#define PG8_STAGE(bufoff, gbase, voff) do { _Pragma("unroll") for (int _i = 0; _i < 2; ++_i) \
        __builtin_amdgcn_global_load_lds((const unsigned*)((const char*)(gbase) + (voff)[_i]), (PG8_LAS unsigned*)(lds + (bufoff) + ldsw + _i * 8192), 16, 0, 0); } while (0)
#define PG8_LDA(dst, b, h) do { _Pragma("unroll") for (int m = 0; m < 4; ++m) _Pragma("unroll") for (int k = 0; k < 2; ++k) dst[m][k] = *(const PG8_LAS bf16x8*)(lds + PG8_SA(b, h) + aoff + m * 2048 + k * 1024); } while (0)
#define PG8_LDB(dst, b, h) do { _Pragma("unroll") for (int n = 0; n < 2; ++n) _Pragma("unroll") for (int k = 0; k < 2; ++k) dst[n][k] = *(const PG8_LAS bf16x8*)(lds + PG8_SB(b, h) + boff + n * 2048 + k * 1024); } while (0)
#define PG8_MMA(ai, bj, At, Bt) do { __builtin_amdgcn_s_setprio(1); _Pragma("unroll") for (int m = 0; m < 4; ++m) _Pragma("unroll") for (int n = 0; n < 2; ++n) _Pragma("unroll") for (int k = 0; k < 2; ++k) \
        acc[ai][bj][m][n] = __builtin_amdgcn_mfma_f32_16x16x32_bf16(Bt[n][k], At[m][k], acc[ai][bj][m][n], 0, 0, 0); __builtin_amdgcn_s_setprio(0); } while (0)
#define PG8_WAIT_V(n) asm volatile("s_waitcnt vmcnt(" #n ")" ::: "memory")
#define PG8_WAIT_L(n) asm volatile("s_waitcnt lgkmcnt(" #n ")" ::: "memory")
#define PG8_BAR __builtin_amdgcn_s_barrier()
#define PG8_SCHED __builtin_amdgcn_sched_barrier(0)
    Unit cur, nxt; int ui = 0;
    if (!S.next(0, cur)) return;
    f32x4 acc[2][2][4][2];
#pragma unroll
    for (int a = 0; a < 2; ++a)
#pragma unroll
        for (int b = 0; b < 2; ++b)
#pragma unroll
            for (int m = 0; m < 4; ++m)
#pragma unroll
                for (int n = 0; n < 2; ++n) acc[a][b][m][n] = (f32x4){0.f, 0.f, 0.f, 0.f};
    bf16x8 At[4][2], B0[2][2], B1[2][2];
    const char* cA = (const char*)g.A + (size_t)cur.pm * tstep; const char* cB = (const char*)g.Bt + (size_t)cur.pn * tstep;
    S.a_ready(cur);
    if constexpr (SP2) {
        PG8_STAGE(PG8_SB(0, 0), cB, voffB); PG8_STAGE(PG8_SB(0, 1), cB + hstep, voffB); PG8_STAGE(PG8_SA(0, 0), cA, voffA); PG8_STAGE(PG8_SA(0, 1), cA + hstep, voffA);
        if (wr == 1) PG8_BAR;
        PG8_WAIT_V(2); PG8_BAR;
        PG8_STAGE(PG8_SB(1, 0), cB + kstep, voffB); PG8_STAGE(PG8_SA(1, 0), cA + kstep, voffA); PG8_STAGE(PG8_SB(1, 1), cB + hstep + kstep, voffB);
        PG8_WAIT_V(6); PG8_BAR;
    } else {
        PG8_STAGE(PG8_SB(0, 0), cB, voffB); PG8_STAGE(PG8_SA(0, 0), cA, voffA); PG8_STAGE(PG8_SB(0, 1), cB + hstep, voffB); PG8_STAGE(PG8_SA(0, 1), cA + hstep, voffA);
        if (wr == 1) PG8_BAR;
        PG8_WAIT_V(4); PG8_BAR;
        PG8_STAGE(PG8_SB(1, 0), cB + kstep, voffB); PG8_STAGE(PG8_SA(1, 0), cA + kstep, voffA); PG8_STAGE(PG8_SB(1, 1), cB + hstep + kstep, voffB);
        PG8_WAIT_V(6); PG8_BAR;
    }
    for (;;) {
        const bool has_next = S.next(ui + 1, nxt);
        const char* nA = has_next ? (const char*)g.A + (size_t)nxt.pm * tstep : cA; const char* nB = has_next ? (const char*)g.Bt + (size_t)nxt.pn * tstep : cB;
        for (int t = 0; t < nt; t += 2) {
            const bool last = (t == nt - 2);
            const char* a1 = cA + (size_t)(t + 1) * kstep;
            const char* a2 = last ? nA : cA + (size_t)(t + 2) * kstep; const char* b2 = last ? nB : cB + (size_t)(t + 2) * kstep;
            const char* a3 = a2 + kstep; const char* b3 = b2 + kstep;
            if (last && has_next) S.a_ready(nxt);
            if constexpr (SP2) {
            PG8_LDB(B0, 0, 0); PG8_LDB(B1, 0, 1); PG8_SCHED; PG8_LDA(At, 0, 0); PG8_STAGE(PG8_SA(1, 1), a1 + hstep, voffA);
            PG8_WAIT_V(8); PG8_WAIT_L(0); PG8_BAR; PG8_MMA(0, 0, At, B0); PG8_MMA(0, 1, At, B1); PG8_BAR; PG8_SCHED;
            PG8_LDA(At, 0, 1); PG8_STAGE(PG8_SB(0, 0), b2, voffB); PG8_STAGE(PG8_SB(0, 1), b2 + hstep, voffB); PG8_STAGE(PG8_SA(0, 0), a2, voffA);
            PG8_WAIT_V(8); PG8_WAIT_L(0); PG8_BAR; PG8_MMA(1, 0, At, B0); PG8_MMA(1, 1, At, B1); PG8_BAR; PG8_SCHED;
            PG8_LDB(B0, 1, 0); PG8_LDB(B1, 1, 1); PG8_SCHED; PG8_LDA(At, 1, 0); PG8_STAGE(PG8_SA(0, 1), a2 + hstep, voffA);
            PG8_WAIT_V(8); PG8_WAIT_L(0); PG8_BAR; PG8_MMA(0, 0, At, B0); PG8_MMA(0, 1, At, B1); PG8_BAR; PG8_SCHED;
            PG8_LDA(At, 1, 1); PG8_STAGE(PG8_SB(1, 0), b3, voffB); PG8_STAGE(PG8_SB(1, 1), b3 + hstep, voffB); PG8_STAGE(PG8_SA(1, 0), a3, voffA);
            PG8_WAIT_V(8); PG8_WAIT_L(0); PG8_BAR; PG8_MMA(1, 0, At, B0); PG8_MMA(1, 1, At, B1); PG8_BAR; PG8_SCHED;
            } else {
            PG8_LDB(B0, 0, 0); PG8_SCHED; PG8_LDA(At, 0, 0); PG8_STAGE(PG8_SA(1, 1), a1 + hstep, voffA);
            PG8_WAIT_L(8); PG8_BAR; PG8_WAIT_L(0); PG8_MMA(0, 0, At, B0); PG8_BAR; PG8_SCHED;
            PG8_LDB(B1, 0, 1); PG8_STAGE(PG8_SB(0, 0), b2, voffB);
            PG8_BAR; PG8_WAIT_L(0); PG8_MMA(0, 1, At, B1); PG8_BAR;
            PG8_LDA(At, 0, 1); PG8_STAGE(PG8_SA(0, 0), a2, voffA);
            PG8_BAR; PG8_WAIT_L(0); PG8_MMA(1, 0, At, B0); PG8_BAR; PG8_SCHED;
            PG8_STAGE(PG8_SB(0, 1), b2 + hstep, voffB);
            PG8_WAIT_V(6); PG8_BAR; PG8_MMA(1, 1, At, B1); PG8_BAR;
            PG8_LDB(B0, 1, 0); PG8_SCHED; PG8_LDA(At, 1, 0); PG8_STAGE(PG8_SA(0, 1), a2 + hstep, voffA);
            PG8_WAIT_L(8); PG8_BAR; PG8_WAIT_L(0); PG8_MMA(0, 0, At, B0); PG8_BAR; PG8_SCHED;
            PG8_LDB(B1, 1, 1); PG8_STAGE(PG8_SB(1, 0), b3, voffB);
            PG8_BAR; PG8_WAIT_L(0); PG8_MMA(0, 1, At, B1); PG8_BAR;
            PG8_LDA(At, 1, 1); PG8_STAGE(PG8_SA(1, 0), a3, voffA);
            PG8_BAR; PG8_WAIT_L(0); PG8_MMA(1, 0, At, B0); PG8_BAR; PG8_SCHED;
            PG8_STAGE(PG8_SB(1, 1), b3 + hstep, voffB);
            PG8_WAIT_V(6); PG8_BAR; PG8_MMA(1, 1, At, B1); PG8_BAR;
            }
        }
        if constexpr (ALIGN_EPI) { if (wr == 0) PG8_BAR; }
        E(acc, cur, wr, wc, fr, fq);
        if (!has_next) break;
#pragma unroll
        for (int a = 0; a < 2; ++a)
#pragma unroll
            for (int b = 0; b < 2; ++b)
#pragma unroll
                for (int m = 0; m < 4; ++m)
#pragma unroll
                    for (int n = 0; n < 2; ++n) acc[a][b][m][n] = (f32x4){0.f, 0.f, 0.f, 0.f};
        cur = nxt; cA = nA; cB = nB; ++ui;
        if constexpr (ALIGN_EPI) { if (wr == 1) PG8_BAR; }
    }
    PG8_WAIT_V(0);
    if constexpr (!ALIGN_EPI) { if (wr == 0) PG8_BAR; }
    PG8_BAR;
#undef PG8_SA
#undef PG8_SB
#undef PG8_STAGE
#undef PG8_LDA
#undef PG8_LDB
#undef PG8_MMA
#undef PG8_WAIT_V
#undef PG8_WAIT_L
#undef PG8_BAR
#undef PG8_SCHED
}
}

__device__ __forceinline__ float row_rstd(const float* PART, int row, int fq, int lane) {
    const f32x4 p = *(const f32x4*)(PART + (size_t)row * 16 + 4 * fq); float sacc = (p.x + p.y) + (p.z + p.w);
    sacc = x16_sum(sacc); sacc = x32_sum(sacc);
    return rsqrtf(sacc * (1.f / D) + EPS);
}
struct EpiScaledBf16 {
    static constexpr bool PERM = true, AFTER_DRAIN = false;
    bf16_t* O; int ldc; const float* PART; const float* SB;
    __device__ __forceinline__ void operator()(const f32x4 (&acc)[2][2][4][2], const pg8::Unit& u, int wr, int wc, int fr, int fq) const {
        asm volatile("" : "+v"(fr), "+v"(fq));
        const int row0 = u.pm * 256 + wr * 64 + fr, col0 = u.pn * 256 + wc * 32 + 8 * fq;
        const int cond = u.pm < 32 ? 0 : 1 + ((u.pm - 32) >> 2);
        const float* sp = SB + (size_t)cond * ldc + col0;
        f32x4 sb[2][2];
#pragma unroll
        for (int bj = 0; bj < 2; ++bj) { sb[bj][0] = *(const f32x4*)(sp + bj * 128); sb[bj][1] = *(const f32x4*)(sp + bj * 128 + 4); }
        float rsv[2][4];
#pragma unroll
        for (int ai = 0; ai < 2; ++ai)
#pragma unroll
            for (int m = 0; m < 4; ++m) rsv[ai][m] = row_rstd(PART, row0 + ai * 128 + m * 16, fq, fr + 16 * fq);
#pragma unroll
        for (int ai = 0; ai < 2; ++ai)
#pragma unroll
            for (int m = 0; m < 4; ++m) { const int row = row0 + ai * 128 + m * 16; const float rs = rsv[ai][m];
                bf16_t* rowp = O + (size_t)row * ldc + col0;
#pragma unroll
                for (int bj = 0; bj < 2; ++bj) { const f32x4 v0 = acc[ai][bj][m][0] * rs + sb[bj][0], v1 = acc[ai][bj][m][1] * rs + sb[bj][1];
                    u32x4 w; w.x = cvt_pk_bf16(v0[0], v0[1]); w.y = cvt_pk_bf16(v0[2], v0[3]); w.z = cvt_pk_bf16(v1[0], v1[1]); w.w = cvt_pk_bf16(v1[2], v1[3]);
                    *(u32x4*)(rowp + bj * 128) = w; }
                asm volatile("" ::: "memory"); }
    }
};
struct EpiResid {
    static constexpr bool PERM = true, AFTER_DRAIN = false;
    float* X; const float* gate_base;
    bf16_t* XG; const float* g_next; const float* scale_next; float* PART;
    const float* XinP; const float* XinS;
    __device__ __forceinline__ void operator()(const f32x4 (&acc)[2][2][4][2], const pg8::Unit& u, int wr, int wc, int fr, int fq) const {
        asm volatile("" : "+v"(fr), "+v"(fq));
        const int row0 = u.pm * 256 + wr * 64 + fr, col0 = u.pn * 256 + wc * 32 + 8 * fq;
        const int cond = u.pm < 32 ? 0 : 1 + ((u.pm - 32) >> 2);
        const float* gp = gate_base + (size_t)cond * 6144 + col0;
        const bool nxt = XG != nullptr;
        f32x4 gv[2][2], gs[2][2];
#pragma unroll
        for (int bj = 0; bj < 2; ++bj)
#pragma unroll
            for (int n = 0; n < 2; ++n) { gv[bj][n] = *(const f32x4*)(gp + bj * 128 + n * 4);
                gs[bj][n] = nxt ? *(const f32x4*)(g_next + col0 + bj * 128 + n * 4) * (*(const f32x4*)(scale_next + (size_t)cond * 6144 + col0 + bj * 128 + n * 4) + 1.f) : (f32x4){0.f, 0.f, 0.f, 0.f}; }
        f32x4 xin[2][4];
#define ER_LOAD(slot, gi) do { const float* rp_ = xin_ + (size_t)(row0 + ((gi) >> 2) * 128 + ((gi) & 3) * 16) * 1024 + col0; \
        xin[slot][0] = *(const f32x4*)rp_; xin[slot][1] = *(const f32x4*)(rp_ + 4); xin[slot][2] = *(const f32x4*)(rp_ + 128); xin[slot][3] = *(const f32x4*)(rp_ + 132); } while (0)
        const float* xin_ = u.pm < 32 ? XinP : XinS - (size_t)NPROMPT * 1024;
        ER_LOAD(0, 0);
#pragma unroll
        for (int gi = 0; gi < 8; ++gi) { const int ai = gi >> 2, m = gi & 3, sl = gi & 1;
            if (gi + 1 < 8) ER_LOAD((gi + 1) & 1, gi + 1);
            asm volatile("" ::: "memory");
            const int row = row0 + ai * 128 + m * 16; float* rowp = X + (size_t)row * 1024 + col0; float ss = 0.f;
#pragma unroll
            for (int bj = 0; bj < 2; ++bj) {
                const f32x4 o0 = xin[sl][2 * bj] + gv[bj][0] * acc[ai][bj][m][0], o1 = xin[sl][2 * bj + 1] + gv[bj][1] * acc[ai][bj][m][1];
                *(f32x4*)(rowp + bj * 128) = o0; *(f32x4*)(rowp + bj * 128 + 4) = o1;
                if (nxt) { ss += ((o0.x * o0.x + o0.y * o0.y) + (o0.z * o0.z + o0.w * o0.w)) + ((o1.x * o1.x + o1.y * o1.y) + (o1.z * o1.z + o1.w * o1.w));
                    const f32x4 x0 = o0 * gs[bj][0], x1 = o1 * gs[bj][1];
                    u32x4 w; w.x = cvt_pk_bf16(x0.x, x0.y); w.y = cvt_pk_bf16(x0.z, x0.w); w.z = cvt_pk_bf16(x1.x, x1.y); w.w = cvt_pk_bf16(x1.z, x1.w);
                    *(u32x4*)(XG + (size_t)row * 1024 + col0 + bj * 128) = w; } }
            if (nxt) { ss = x16_sum(ss); ss = x32_sum(ss); if (fq == 0) PART[(size_t)row * 16 + u.pn * 4 + wc] = ss; }
        }
#undef ER_LOAD
    }
};
#define DPPU_ROR1(x) ((unsigned)__builtin_amdgcn_update_dpp(0, (int)(x), 0x121, 0xF, 0xF, false))
#define DPPU_ROL1(x) ((unsigned)__builtin_amdgcn_update_dpp(0, (int)(x), 0x12F, 0xF, 0xF, false))
struct EpiFfnAct {
    static constexpr bool PERM = true, AFTER_DRAIN = false;
    bf16_t* A2; const float* PART; const float* SB; const float* cw; const float* cb; bf16_t* EDGE; LAS unsigned char* xch;
    __device__ __forceinline__ void operator()(f32x4 (&acc)[2][2][4][2], const pg8::Unit& u, int wr, int wc, int, int) const {
        const int t_ = opaque_tid(), fr = t_ & 15, fq = (t_ >> 4) & 3;
        const int row0 = u.pm * 256 + wr * 64 + fr;
        const int cc0 = wc * 32 + 8 * fq, ucol = u.pn * 256 + cc0, chan = u.pn * 128 + cc0;
        const int cond = u.pm < 32 ? 0 : 1 + ((u.pm - 32) >> 2);
        unsigned pu[2][2][4][2][2];
        {
            const float* sp = SB + (size_t)cond * NFF2 + ucol;
            f32x4 sb[2][2];
#pragma unroll
            for (int bj = 0; bj < 2; ++bj) { sb[bj][0] = *(const f32x4*)(sp + bj * 128); sb[bj][1] = *(const f32x4*)(sp + bj * 128 + 4); }
            float rsv[2][4];
#pragma unroll
            for (int ai = 0; ai < 2; ++ai)
#pragma unroll
                for (int m = 0; m < 4; ++m) rsv[ai][m] = row_rstd(PART, row0 + ai * 128 + m * 16, fq, fr + 16 * fq);
#pragma unroll
            for (int ai = 0; ai < 2; ++ai)
#pragma unroll
                for (int m = 0; m < 4; ++m)
#pragma unroll
                    for (int bj = 0; bj < 2; ++bj)
#pragma unroll
                        for (int n = 0; n < 2; ++n) { const f32x4 v = acc[ai][bj][m][n] * rsv[ai][m] + sb[bj][n]; pu[ai][bj][m][n][0] = cvt_pk_bf16(v[0], v[1]); pu[ai][bj][m][n][1] = cvt_pk_bf16(v[2], v[3]); }
        }
        if (u.pm >= 32) {
            bf16_t* eb = EDGE + (size_t)(u.pm - 32) * 4 * NFF2 + ucol;
            if (wr == 0 && fr < 2) {
#pragma unroll
                for (int bj = 0; bj < 2; ++bj)
#pragma unroll
                    for (int n = 0; n < 2; ++n) *(u32x2*)(eb + (size_t)fr * NFF2 + bj * 128 + 4 * n) = (u32x2){pu[0][bj][0][n][0], pu[0][bj][0][n][1]}; }
            if (wr == 1 && fr >= 14) {
#pragma unroll
                for (int bj = 0; bj < 2; ++bj)
#pragma unroll
                    for (int n = 0; n < 2; ++n) *(u32x2*)(eb + (size_t)(fr - 12) * NFF2 + bj * 128 + 4 * n) = (u32x2){pu[1][bj][3][n][0], pu[1][bj][3][n][1]}; }
        }
        LAS u32x2* X2 = (LAS u32x2*)xch; const int wave = wr * 4 + wc;
        if (fr == 0) {
#pragma unroll
            for (int ai = 0; ai < 2; ++ai)
#pragma unroll
                for (int bj = 0; bj < 2; ++bj)
#pragma unroll
                    for (int n = 0; n < 2; ++n) X2[((((wave * 2 + ai) * 2 + 0) * 4 + bj * 2 + n) * 4) + fq] = (u32x2){pu[ai][bj][0][n][0], pu[ai][bj][0][n][1]}; }
        if (fr == 15) {
#pragma unroll
            for (int ai = 0; ai < 2; ++ai)
#pragma unroll
                for (int bj = 0; bj < 2; ++bj)
#pragma unroll
                    for (int n = 0; n < 2; ++n) X2[((((wave * 2 + ai) * 2 + 1) * 4 + bj * 2 + n) * 4) + fq] = (u32x2){pu[ai][bj][3][n][0], pu[ai][bj][3][n][1]}; }
        asm volatile("s_waitcnt lgkmcnt(0)\n\ts_barrier" ::: "memory");
        const LAS unsigned* XU = (const LAS unsigned*)xch;
#pragma unroll
        for (int n = 0; n < 2; ++n) {
#pragma unroll
            for (int ai = 0; ai < 2; ++ai) {
                const bool hasp = !(wr == 0 && ai == 0), hasn = !(wr == 1 && ai == 1);
                const int pw = wr == 1 ? wc : 4 + wc, pa = wr == 1 ? ai : 0;
                const int nw = wr == 0 ? 4 + wc : wc, na = wr == 0 ? ai : 1;
                const int pbase = (((((pw * 2 + pa) * 2 + 1) * 4 + n) * 4) + fq) * 2, nbase = (((((nw * 2 + na) * 2 + 0) * 4 + n) * 4) + fq) * 2;
                unsigned op[4][2];
#pragma unroll
                for (int ep = 0; ep < 2; ++ep) {
                    const int c2 = chan + 4 * n + 2 * ep;
                    const f32x2 wv0 = *(const f32x2*)(cw + c2), wv1 = *(const f32x2*)(cw + NFF2 + c2), wv2 = *(const f32x2*)(cw + 2 * NFF2 + c2), bvv = *(const f32x2*)(cb + c2);
                    const f32x2 wg0 = *(const f32x2*)(cw + NFF + c2), wg1 = *(const f32x2*)(cw + NFF2 + NFF + c2), wg2 = *(const f32x2*)(cw + 2 * NFF2 + NFF + c2), bgv = *(const f32x2*)(cb + NFF + c2);
                    float vc[4][2], gc[4][2];
#pragma unroll
                    for (int bj = 0; bj < 2; ++bj) {
                        const unsigned pe = hasp ? XU[pbase + bj * 16 + ep] : 0u, ne = hasn ? XU[nbase + bj * 16 + ep] : 0u;
                        const f32x2 w0 = bj == 0 ? wv0 : wg0, w1 = bj == 0 ? wv1 : wg1, w2 = bj == 0 ? wv2 : wg2, bb = bj == 0 ? bvv : bgv;
#pragma unroll
                        for (int m = 0; m < 4; ++m) {
                            const unsigned am = pu[ai][bj][m][n][ep];
                            const unsigned rm = DPPU_ROR1(am), lm = DPPU_ROL1(am);
                            const unsigned rp = m > 0 ? DPPU_ROR1(pu[ai][bj][m > 0 ? m - 1 : 0][n][ep]) : pe;
                            const unsigned ln = m < 3 ? DPPU_ROL1(pu[ai][bj][m < 3 ? m + 1 : 3][n][ep]) : ne;
                            const unsigned pm_ = fr == 0 ? rp : rm, qm_ = fr == 15 ? ln : lm;
                            const float r0 = bb.x + w0.x * bflo(pm_) + w1.x * bflo(am) + w2.x * bflo(qm_), r1 = bb.y + w0.y * bfhi(pm_) + w1.y * bfhi(am) + w2.y * bfhi(qm_);
                            if (bj == 0) { vc[m][0] = r0; vc[m][1] = r1; } else { gc[m][0] = r0; gc[m][1] = r1; }
                        }
                    }
#pragma unroll
                    for (int m = 0; m < 4; ++m) op[m][ep] = cvt_pk_bf16(siluf_(gc[m][0]) * vc[m][0], siluf_(gc[m][1]) * vc[m][1]);
                }
#pragma unroll
                for (int m = 0; m < 4; ++m) *(u32x2*)(A2 + (size_t)(row0 + ai * 128 + m * 16) * NFF + chan + 4 * n) = (u32x2){op[m][0], op[m][1]};
                asm volatile("" ::: "memory");
            }
        }
    }
};
__device__ __forceinline__ void ffn_fix_phase(const bf16_t* EDGE, const float* cw, const float* cb, bf16_t* A2) {
    const int gtid = blockIdx.x * 512 + opaque_tid(), nthreads = gridDim.x * 512;
    for (int it = gtid; it < 8 * 3 * 2 * (NFF / 8); it += nthreads) {
        const int cg8 = it % (NFF / 8), r = it / (NFF / 8), which = r & 1, bnd = (r >> 1) % 3, b = r / 6;
        const int c = cg8 * 8, ucol = 256 * (c >> 7) + (c & 127);
        const int tA = b * 4 + bnd, tB = tA + 1;
        const bf16_t* pr = EDGE + ((size_t)tA * 4 + (which == 0 ? 2 : 3)) * NFF2 + ucol;
        const bf16_t* cr = which == 0 ? EDGE + ((size_t)tA * 4 + 3) * NFF2 + ucol : EDGE + ((size_t)tB * 4 + 0) * NFF2 + ucol;
        const bf16_t* nr = EDGE + ((size_t)tB * 4 + (which == 0 ? 0 : 1)) * NFF2 + ucol;
        const int grow = NPROMPT + b * 1024 + (bnd + 1) * 256 - 1 + which;
        float pv[8], pg[8], cv[8], cgv[8], nv[8], ng[8], o[8];
        unpack8(*(const u32x4*)pr, pv); unpack8(*(const u32x4*)(pr + 128), pg); unpack8(*(const u32x4*)cr, cv); unpack8(*(const u32x4*)(cr + 128), cgv);
        unpack8(*(const u32x4*)nr, nv); unpack8(*(const u32x4*)(nr + 128), ng);
#pragma unroll
        for (int e = 0; e < 8; ++e) {
            const float val = cb[c + e] + cw[c + e] * pv[e] + cw[NFF2 + c + e] * cv[e] + cw[2 * NFF2 + c + e] * nv[e];
            const float gg = cb[NFF + c + e] + cw[NFF + c + e] * pg[e] + cw[NFF2 + NFF + c + e] * cgv[e] + cw[2 * NFF2 + NFF + c + e] * ng[e];
            o[e] = siluf_(gg) * val; }
        *(u32x4*)(A2 + (size_t)grow * NFF + c) = pack8(o);
    }
}
__device__ __forceinline__ void ffn_fix_row(const bf16_t* EDGE, const float* cw, const float* cb, bf16_t* A2, int tA, int which, int c) {
    const int ucol = 256 * (c >> 7) + (c & 127), tB = tA + 1;
    const bf16_t* pr = EDGE + ((size_t)tA * 4 + (which == 0 ? 2 : 3)) * NFF2 + ucol;
    const bf16_t* cr = which == 0 ? EDGE + ((size_t)tA * 4 + 3) * NFF2 + ucol : EDGE + ((size_t)tB * 4 + 0) * NFF2 + ucol;
    const bf16_t* nr = EDGE + ((size_t)tB * 4 + (which == 0 ? 0 : 1)) * NFF2 + ucol;
    const int grow = NPROMPT + (tA + 1) * 256 - 1 + which;
    float pv[8], pg[8], cv[8], cgv[8], nv[8], ng[8], o[8];
    unpack8(*(const u32x4*)pr, pv); unpack8(*(const u32x4*)(pr + 128), pg); unpack8(*(const u32x4*)cr, cv); unpack8(*(const u32x4*)(cr + 128), cgv);
    unpack8(*(const u32x4*)nr, nv); unpack8(*(const u32x4*)(nr + 128), ng);
#pragma unroll
    for (int e = 0; e < 8; ++e) {
        const float val = cb[c + e] + cw[c + e] * pv[e] + cw[NFF2 + c + e] * cv[e] + cw[2 * NFF2 + c + e] * nv[e];
        const float gg = cb[NFF + c + e] + cw[NFF + c + e] * pg[e] + cw[NFF2 + NFF + c + e] * cgv[e] + cw[2 * NFF2 + NFF + c + e] * ng[e];
        o[e] = siluf_(gg) * val; }
    *(u32x4*)(A2 + (size_t)grow * NFF + c) = pack8(o);
}
__device__ __forceinline__ void ffn_fix_panel(const bf16_t* EDGE, const float* cw, const float* cb, bf16_t* A2, int pm) {
    if (pm < 32) return;
    const int t = pm - 32, k = t & 3, tid = opaque_tid();
    for (int it = tid; it < 2 * (NFF / 8); it += 512) { const int which = it / (NFF / 8), c = (it % (NFF / 8)) * 8;
        if (which == 1 && k > 0) ffn_fix_row(EDGE, cw, cb, A2, t - 1, 1, c);
        if (which == 0 && k < 3) ffn_fix_row(EDGE, cw, cb, A2, t, 0, c); }
}
struct EpiInEven {
    static constexpr bool PERM = true, AFTER_DRAIN = false;
    bf16_t* P1; float* DT; float* outK; float* outV; const float* rope; int j; const float* PART; const float* SB;
    __device__ __forceinline__ void operator()(const f32x4 (&acc)[2][2][4][2], const pg8::Unit& u, int wr, int wc, int fr, int fq) const {
        asm volatile("" : "+v"(fr), "+v"(fq));
        const int pn = u.pn; const int row0 = u.pm * 256 + wr * 64 + fr, col0 = pn * 256 + wc * 32 + 8 * fq;
        const bool sample = u.pm >= 32;
        const int cond = u.pm < 32 ? 0 : 1 + ((u.pm - 32) >> 2);
        const float* sp = SB + (size_t)cond * NIN_E + col0;
        if (pn == 9) {
            if (wc == 0) { const f32x4 sb0 = *(const f32x4*)sp, sb1 = *(const f32x4*)(sp + 4);
#pragma unroll
                for (int ai = 0; ai < 2; ++ai)
#pragma unroll
                    for (int m = 0; m < 4; ++m) { const int row = row0 + ai * 128 + m * 16; const float rs = row_rstd(PART, row, fq, fr + 16 * fq); float* dp = DT + (size_t)row * 32 + 8 * fq;
                        *(f32x4*)dp = acc[ai][0][m][0] * rs + sb0; *(f32x4*)(dp + 4) = acc[ai][0][m][1] * rs + sb1; }
            }
            return;
        }
        f32x4 sb[2][2];
#pragma unroll
        for (int bj = 0; bj < 2; ++bj) { sb[bj][0] = *(const f32x4*)(sp + bj * 128); sb[bj][1] = *(const f32x4*)(sp + bj * 128 + 4); }
        const bool rope_on = sample && pn >= 10 && pn < 18;
        const bool kv_out = (!sample) && pn >= 14;
        float* ob = nullptr; int ocol = 0;
        if (kv_out) { ob = pn < 18 ? outK : outV; ocol = col0 - (pn < 18 ? COL_K : COL_V); }
#pragma unroll
        for (int ai = 0; ai < 2; ++ai) {
            float rsv[4];
#pragma unroll
            for (int m = 0; m < 4; ++m) rsv[m] = row_rstd(PART, row0 + ai * 128 + m * 16, fq, fr + 16 * fq);
#pragma unroll
            for (int m = 0; m < 4; ++m) {
                const int row = row0 + ai * 128 + m * 16; const float rs = rsv[m];
                f32x4 cs0 = {1.f, 1.f, 1.f, 1.f}, cs1 = cs0, sn0 = {0.f, 0.f, 0.f, 0.f}, sn1 = sn0;
                if (rope_on) { const int t = (row - NPROMPT) & 1023; const int pos = (wc & 1) ? (t & 63) : (t >> 6);
                    const float* rp = rope + pos * 16 + 8 * (fq & 1);
                    cs0 = *(const f32x4*)rp; cs1 = *(const f32x4*)(rp + 4); sn0 = *(const f32x4*)(rp + 1024); sn1 = *(const f32x4*)(rp + 1024 + 4); }
                bf16_t* rowp = P1 + (size_t)row * NIN_E + col0;
#pragma unroll
                for (int bj = 0; bj < 2; ++bj) { f32x4 v0 = acc[ai][bj][m][0] * rs + sb[bj][0], v1 = acc[ai][bj][m][1] * rs + sb[bj][1];
                    if (rope_on) {
                        f32x4 p0, p1;
#pragma unroll
                        for (int e = 0; e < 4; ++e) { p0[e] = shfl_xor_l(v0[e], 32, fr + 16 * fq); p1[e] = shfl_xor_l(v1[e], 32, fr + 16 * fq); }
                        if (fq < 2) { v0 = v0 * cs0 - p0 * sn0; v1 = v1 * cs1 - p1 * sn1; }
                        else        { v0 = p0 * sn0 + v0 * cs0; v1 = p1 * sn1 + v1 * cs1; }
                    }
                    if (pn >= 10 && pn < 14) { v0 = v0 * QSCALE; v1 = v1 * QSCALE; }
                    u32x4 w; w.x = cvt_pk_bf16(v0[0], v0[1]); w.y = cvt_pk_bf16(v0[2], v0[3]); w.z = cvt_pk_bf16(v1[0], v1[1]); w.w = cvt_pk_bf16(v1[2], v1[3]);
                    *(u32x4*)(rowp + bj * 128) = w;
                    if (kv_out) { const int b = row >> 8, t = row & 255; float* op = ob + ((size_t)(b * 2 + j) * 256 + t) * 1024 + ocol + bj * 128;
                        *(f32x4*)op = v0; *(f32x4*)(op + 4) = v1; }
                }
                asm volatile("" ::: "memory");
            }
        }
    }
};

#define GAS __attribute__((address_space(1)))
typedef const GAS float* gcfp;
struct Params {
    gcfp in[38];
    GAS float* out;
    GAS unsigned char* ws;
};

__device__ __forceinline__ void transpose_item(const float* W, int K, int N, bf16_t* WT, int row_shift_from, int row_shift, LAS float* scr, int item, int lane) {
    const int nblk = N / 32, kb = item / nblk, nb = item % nblk, k0 = 64 * kb, n0 = 32 * nb;
    float tv[32];
#pragma unroll
    for (int i = 0; i < 32; ++i) { const int kk = 2 * i + (lane >> 5); tv[i] = W[(size_t)(k0 + kk) * N + n0 + (lane & 31)]; }
#pragma unroll
    for (int i = 0; i < 32; ++i) { const int kk = 2 * i + (lane >> 5); scr[kk * 33 + (lane & 31)] = tv[i]; }
    CBAR();
    const int c = lane & 7;
    const int drow0 = row_shift_from < 0 ? (n0 < NFF ? 256 * (n0 / 128) + (n0 % 128) : 256 * ((n0 - NFF) / 128) + 128 + ((n0 - NFF) % 128)) : n0 + (n0 >= row_shift_from ? row_shift : 0);
#pragma unroll
    for (int jx = 0; jx < 4; ++jx) { const int n = (lane >> 3) + 8 * jx; const LAS float* s = scr + (8 * c) * 33 + n;
        u32x4 o; o.x = cvt_pk_bf16(s[0 * 33], s[1 * 33]); o.y = cvt_pk_bf16(s[2 * 33], s[3 * 33]); o.z = cvt_pk_bf16(s[4 * 33], s[5 * 33]); o.w = cvt_pk_bf16(s[6 * 33], s[7 * 33]);
        *(u32x4*)(WT + (size_t)(drow0 + n) * K + k0 + 8 * c) = o; }
    CBAR();
}

template <int MODE, bool FROM_INPUT>
__device__ __forceinline__ void norm_rows(const float* xp, const float* xs, float* X, const float* g, const float* mod_l, int shift_chunk, bf16_t* hout) {
    const int tid_ = opaque_tid(), lane = tid_ & 63, gw = blockIdx.x * 8 + (tid_ >> 6), NGW = gridDim.x * 8;
    f32x4 gv[4];
#pragma unroll
    for (int jx = 0; jx < 4; ++jx) gv[jx] = *(const f32x4*)(g + 4 * lane + 256 * jx);
    for (int m = gw; m < NTOK; m += NGW) {
        const float* src = FROM_INPUT ? (m < NPROMPT ? xp + (size_t)m * D : xs + (size_t)(m - NPROMPT) * D) : X + (size_t)m * D;
        f32x4 v[4]; float ss = 0.f;
#pragma unroll
        for (int jx = 0; jx < 4; ++jx) { v[jx] = *(const f32x4*)(src + 4 * lane + 256 * jx); ss += (v[jx].x * v[jx].x + v[jx].y * v[jx].y) + (v[jx].z * v[jx].z + v[jx].w * v[jx].w); }
        if (FROM_INPUT) {
#pragma unroll
            for (int jx = 0; jx < 4; ++jx) *(f32x4*)(X + (size_t)m * D + 4 * lane + 256 * jx) = v[jx];
        }
        const float rstd = rsqrtf(wave_sum(ss, lane) * (1.f / D) + EPS);
        if (MODE == 0) {
            const int cond = m < NPROMPT ? 0 : 1 + ((m - NPROMPT) >> 10);
            const float* mp = mod_l + (size_t)cond * 6144 + shift_chunk * 1024;
#pragma unroll
            for (int jx = 0; jx < 4; ++jx) { const f32x4 sh = *(const f32x4*)(mp + 4 * lane + 256 * jx), sc = *(const f32x4*)(mp + 1024 + 4 * lane + 256 * jx);
                const f32x4 y = v[jx] * rstd * gv[jx]; const f32x4 hh = y * (sc + 1.f) + sh;
                u32x2 w; w.x = cvt_pk_bf16(hh.x, hh.y); w.y = cvt_pk_bf16(hh.z, hh.w);
                *(u32x2*)(hout + (size_t)m * D + 4 * lane + 256 * jx) = w; }
        } else {
#pragma unroll
            for (int jx = 0; jx < 4; ++jx) *(f32x4*)(X + (size_t)m * D + 4 * lane + 256 * jx) = v[jx] * rstd * gv[jx];
        }
    }
}

__device__ __forceinline__ void first_rows(const float* xp, const float* xs, float* X, const float* g, const float* mod0, bf16_t* XG, float* PART) {
    const int tid_ = opaque_tid(), lane = tid_ & 63, gw = blockIdx.x * 8 + (tid_ >> 6), NGW = gridDim.x * 8;
    f32x4 gv[4];
#pragma unroll
    for (int jx = 0; jx < 4; ++jx) gv[jx] = *(const f32x4*)(g + 4 * lane + 256 * jx);
    for (int m = gw; m < NTOK; m += NGW) {
        const float* src = m < NPROMPT ? xp + (size_t)m * D : xs + (size_t)(m - NPROMPT) * D;
        f32x4 v[4]; float ss = 0.f;
#pragma unroll
        for (int jx = 0; jx < 4; ++jx) { v[jx] = *(const f32x4*)(src + 4 * lane + 256 * jx); ss += (v[jx].x * v[jx].x + v[jx].y * v[jx].y) + (v[jx].z * v[jx].z + v[jx].w * v[jx].w); }
        ss = wave_sum(ss, lane);
        const int cond = m < NPROMPT ? 0 : 1 + ((m - NPROMPT) >> 10);
        const float* scp = mod0 + (size_t)cond * 6144 + 1024;
#pragma unroll
        for (int jx = 0; jx < 4; ++jx) { const f32x4 sc = *(const f32x4*)(scp + 4 * lane + 256 * jx); const f32x4 xg = v[jx] * gv[jx] * (sc + 1.f);
            u32x2 w; w.x = cvt_pk_bf16(xg.x, xg.y); w.y = cvt_pk_bf16(xg.z, xg.w); *(u32x2*)(XG + (size_t)m * D + 4 * lane + 256 * jx) = w; }
        if (lane < 4) *(f32x4*)(PART + (size_t)m * 16 + 4 * lane) = (f32x4){lane == 0 ? ss : 0.f, 0.f, 0.f, 0.f};
    }
}
__device__ __forceinline__ void sb_gemv_phase(const float* MODp, const bf16_t* WT, int nrows, int lmod, int chunk, float* out, int ostr) {
    const int tid_ = opaque_tid(), lane = tid_ & 63, gw = blockIdx.x * 8 + (tid_ >> 6), NGW = gridDim.x * 8;
    float sh[9][16];
#pragma unroll
    for (int ci = 0; ci < 9; ++ci) { const float* sp = MODp + ((size_t)lmod * 9 + ci) * 6144 + chunk * 1024 + 16 * lane;
#pragma unroll
        for (int q4 = 0; q4 < 4; ++q4) { const f32x4 t = *(const f32x4*)(sp + 4 * q4); sh[ci][4 * q4] = t.x; sh[ci][4 * q4 + 1] = t.y; sh[ci][4 * q4 + 2] = t.z; sh[ci][4 * q4 + 3] = t.w; } }
    for (int n = gw; n < nrows; n += NGW) {
        float w[16]; unpack8(*(const u32x4*)(WT + (size_t)n * 1024 + 16 * lane), w); unpack8(*(const u32x4*)(WT + (size_t)n * 1024 + 16 * lane + 8), w + 8);
        float r[9];
#pragma unroll
        for (int ci = 0; ci < 9; ++ci) { float a = 0.f;
#pragma unroll
            for (int e = 0; e < 16; ++e) a += sh[ci][e] * w[e];
            r[ci] = wave_sum(a, lane); }
        if (lane == 0) {
#pragma unroll
            for (int ci = 0; ci < 9; ++ci) out[(size_t)ci * ostr + n] = r[ci]; }
    }
}

__device__ __forceinline__ void ffn_act_phase(const bf16_t* U, const float* cw, const float* cb, bf16_t* A2) {
    const int gtid = blockIdx.x * 512 + opaque_tid(), nthreads = gridDim.x * 512;
    constexpr int NCG = NFF / 8, RUN = 16, NRUN = NTOK / RUN;
    for (int it = gtid; it < NCG * NRUN; it += nthreads) {
        const int cg8 = it % NCG, run = it / NCG, t0 = run * RUN, col = cg8 * 8;
        const int Lm = t0 < NPROMPT ? 255 : 1023;
        const bool first = (t0 & Lm) == 0, last = ((t0 + RUN) & Lm) == 0;
        float wv[3][8], wg[3][8], bv[8], bg[8];
#pragma unroll
        for (int k = 0; k < 3; ++k) {
#pragma unroll
            for (int e = 0; e < 8; ++e) { wv[k][e] = cw[k * NFF2 + col + e]; wg[k][e] = cw[k * NFF2 + NFF + col + e]; } }
#pragma unroll
        for (int e = 0; e < 8; ++e) { bv[e] = cb[col + e]; bg[e] = cb[NFF + col + e]; }
        float pv[8], pg[8], cv[8], cgv[8], nv[8], ng[8];
        const bf16_t* base = U + (size_t)t0 * NFF2 + 256 * (col >> 7) + (col & 127);
        if (first) {
#pragma unroll
            for (int e = 0; e < 8; ++e) { pv[e] = 0.f; pg[e] = 0.f; } }
        else { unpack8(*(const u32x4*)(base - NFF2), pv); unpack8(*(const u32x4*)(base - NFF2 + 128), pg); }
        unpack8(*(const u32x4*)base, cv); unpack8(*(const u32x4*)(base + 128), cgv);
        for (int i = 0; i < RUN; ++i) {
            if (i == RUN - 1 && last) {
#pragma unroll
                for (int e = 0; e < 8; ++e) { nv[e] = 0.f; ng[e] = 0.f; } }
            else { const bf16_t* nb = base + (size_t)(i + 1) * NFF2; unpack8(*(const u32x4*)nb, nv); unpack8(*(const u32x4*)(nb + 128), ng); }
            float o[8];
#pragma unroll
            for (int e = 0; e < 8; ++e) { const float val = bv[e] + wv[0][e] * pv[e] + wv[1][e] * cv[e] + wv[2][e] * nv[e];
                const float gg = bg[e] + wg[0][e] * pg[e] + wg[1][e] * cgv[e] + wg[2][e] * ng[e]; o[e] = siluf_(gg) * val; }
            *(u32x4*)(A2 + (size_t)(t0 + i) * NFF + col) = pack8(o);
#pragma unroll
            for (int e = 0; e < 8; ++e) { pv[e] = cv[e]; pg[e] = cgv[e]; cv[e] = nv[e]; cgv[e] = ng[e]; }
        }
    }
}

__device__ __forceinline__ void ssd_gate_phase(const bf16_t* YF, const bf16_t* YB, const bf16_t* P1, const float* ng, bf16_t* A2) {
    const int tid_ = opaque_tid(), lane = tid_ & 63, gw = blockIdx.x * 8 + (tid_ >> 6), NGW = gridDim.x * 8;
    for (int m = gw; m < NTOK; m += NGW) {
        float v[2][8]; float ss = 0.f;
#pragma unroll
        for (int jx = 0; jx < 2; ++jx) { const int c = 8 * lane + 512 * jx; float a[8], b[8], z[8];
            unpack8(*(const u32x4*)(YF + (size_t)m * D + c), a); unpack8(*(const u32x4*)(YB + (size_t)m * D + c), b); unpack8(*(const u32x4*)(P1 + (size_t)m * NIN_E + c), z);
#pragma unroll
            for (int e = 0; e < 8; ++e) { const float y = (a[e] + b[e]) * siluf_(z[e]); v[jx][e] = y; ss += y * y; } }
        const float rstd = rsqrtf(wave_sum(ss, lane) * (1.f / D) + EPS);
#pragma unroll
        for (int jx = 0; jx < 2; ++jx) { const int c = 8 * lane + 512 * jx; float o[8];
#pragma unroll
            for (int e = 0; e < 8; ++e) o[e] = v[jx][e] * rstd * ng[c + e];
            *(u32x4*)(A2 + (size_t)m * 2048 + c) = pack8(o); }
    }
}
__device__ __forceinline__ void lru_gate_phase(const bf16_t* YF, const bf16_t* YB, const bf16_t* P1, bf16_t* A2) {
    const int gtid = blockIdx.x * 512 + opaque_tid(), nthreads = gridDim.x * 512;
    for (int it = gtid; it < NTOK * 128; it += nthreads) {
        const int m = it >> 7, c = (it & 127) * 8; float a[8], b[8], gt[8], o[8];
        unpack8(*(const u32x4*)(YF + (size_t)m * D + c), a); unpack8(*(const u32x4*)(YB + (size_t)m * D + c), b); unpack8(*(const u32x4*)(P1 + (size_t)m * 2048 + c), gt);
#pragma unroll
        for (int e = 0; e < 8; ++e) o[e] = (a[e] + b[e]) * gelu_tanh(gt[e]);
        *(u32x4*)(A2 + (size_t)m * D + c) = pack8(o);
    }
}


__device__ __forceinline__ void cache_to_bf16(const float* ck, const float* cv, int j, bf16_t* KC) {
    const int gtid = blockIdx.x * 512 + opaque_tid(), nthreads = gridDim.x * 512;
    for (int it = gtid; it < 2 * 524288; it += nthreads) {
        const int which = it >= 524288, r = it & 524287, b = r >> 16, e8 = r & 65535;
        const float* src = (which ? cv : ck) + ((size_t)(b * 2 + j) * 524288 + (size_t)e8 * 8);
        const f32x4 a = *(const f32x4*)src, c = *(const f32x4*)(src + 4);
        u32x4 w; w.x = cvt_pk_bf16(a.x, a.y); w.y = cvt_pk_bf16(a.z, a.w); w.z = cvt_pk_bf16(c.x, c.y); w.w = cvt_pk_bf16(c.z, c.w);
        *(u32x4*)(KC + (size_t)which * 4194304 + (size_t)b * 524288 + (size_t)e8 * 8) = w;
    }
}

__device__ __forceinline__ void ssd_unit(LAS unsigned char* lds, const bf16_t* P1, const float* DT, int seqrow0, int Lseq, int bidx, bool sample, int h, int j,
                                         const float* conv_w, const float* conv_b, const float* a_log, const float* dt_bias, const float* ssd_d,
                                         const float* st_f, const float* st_b, float* out_f, float* out_b, bf16_t* YF, bf16_t* YB) {
    const int tid = opaque_tid(), wave = __builtin_amdgcn_readfirstlane(tid >> 6), dir = wave >> 2, wq = wave & 3, tg = tid & 255;
    int lane = tid & 63, l15 = lane & 15, lq = lane >> 4;
    LAS unsigned char* base = lds + dir * 65536;
    LAS unsigned char* Cs = base, *Bs = base + 9216, *BTw = base + 18432, *XTs = base + 27648, *Ms = base + 36864;
    const int g = h >> 3;
    const float Aneg = -__expf(a_log[j * 32 + dir * 16 + h]); const float dtb = dt_bias[j * 32 + dir * 16 + h]; const float Dh = ssd_d[j * 16 + h];
    f32x4 Hacc[4];
    {
        const float* st = (dir == 0 ? st_f : st_b) + ((size_t)(bidx * 2 + j) * 16 + h) * 4096;
#pragma unroll
        for (int ni = 0; ni < 4; ++ni)
#pragma unroll
            for (int jj = 0; jj < 4; ++jj) Hacc[ni][jj] = sample ? st[(16 * wq + lq * 4 + jj) * 64 + 16 * ni + l15] : 0.f;
    }
    bf16_t* Y = dir == 0 ? YF : YB;
    const int nch = Lseq >> 6;
    float dtraw = 0.f;
#define SSD_ISSUE(ci) do { const int c_ = dir == 0 ? (ci) : nch - 1 - (ci); const int tb_ = seqrow0 + 64 * c_; \
        if (wq == 0) dtraw = DT[(size_t)(tb_ + lane) * 32 + dir * 16 + h]; } while (0)
#define SSD_PREP(buf) do { LAS unsigned char* Hs_ = base + 46080 + 9216 * (buf); \
        _Pragma("unroll") for (int ni = 0; ni < 4; ++ni) _Pragma("unroll") for (int jj = 0; jj < 4; ++jj) \
            *(LAS unsigned short*)(Hs_ + ((16 * wq + lq * 4 + jj) * 72 + 16 * ni + l15) * 2) = f2bf(Hacc[ni][jj]); \
        if (wq == 0) { const float dtv = softplusf_(dtraw + dtb); const float da = dtv * Aneg; float ps = da; \
            _Pragma("unroll") for (int o = 1; o < 64; o <<= 1) { const float t = shfl_idx_l(ps, lane >= o ? lane - o : lane); if (lane >= o) ps += t; } \
            const float total = shfl_idx_l(ps, 63); \
            ((LAS float*)(base + 64512 + 512 * (buf)))[lane] = dtv; ((LAS float*)(base + 64768 + 512 * (buf)))[lane] = dir == 0 ? ps : (total - ps + da); } } while (0)
    LDS_BARRIER();
    SSD_ISSUE(0);
    SSD_PREP(0);
    for (int i = 0; i < nch; ++i) {
        asm volatile("" : "+v"(lane), "+v"(l15), "+v"(lq));
        const int c = dir == 0 ? i : nch - 1 - i; const int tb = seqrow0 + 64 * c; const int buf = i & 1;
        LAS unsigned char* Hs = base + 46080 + 9216 * buf; LAS float* dts = (LAS float*)(base + 64512 + 512 * buf); LAS float* acss = (LAS float*)(base + 64768 + 512 * buf);
        LDS_BARRIER();
        const float acs_last = acss[dir == 0 ? 63 : 0];
#pragma unroll
        for (int hi = 0; hi < 2; ++hi) {
            if (hi == 1 && wave >= 4) break;
            const int hr = wave < 4 ? 3 * wave + hi : 3 * (wave - 4) + 2;
            const int rdir = hr >= 6 ? 1 : 0, a = (hr - 6 * rdir) >> 1, th = hr & 1;
            const int cgp = a == 0 ? (lane >> 3) : (lane & 7), run = a == 0 ? (lane & 7) : (lane >> 3);
            const int chan = (a == 0 ? h * 64 : (a == 1 ? 1024 + g * 64 : 1152 + g * 64)) + cgp * 8;
            LAS unsigned char* rb = lds + rdir * 65536;
            const LAS float* rdts = (const LAS float*)(rb + 64512 + 512 * buf); const LAS float* racs = (const LAS float*)(rb + 64768 + 512 * buf);
            const int rc = rdir == 0 ? i : nch - 1 - i;
            const float racs_last = racs[rdir == 0 ? 63 : 0];
            const int tl0 = 64 * rc + 8 * run + 4 * th;
            u32x4 raw[7];
#pragma unroll
            for (int r = 0; r < 7; ++r) { const int tt = tl0 - 2 + r;
                raw[r] = (tt >= 0 && tt < Lseq) ? *(const u32x4*)(P1 + (size_t)(seqrow0 + tt) * NIN_E + COL_XBC + chan) : (u32x4){0u, 0u, 0u, 0u}; }
            float wv[4][8], bv[8];
#pragma unroll
            for (int jj = 0; jj < 4; ++jj) { const float* wp = conv_w + (size_t)(j * 4 + jj) * 1280 + chan; const f32x4 w0 = *(const f32x4*)wp, w1 = *(const f32x4*)(wp + 4);
                wv[jj][0] = w0.x; wv[jj][1] = w0.y; wv[jj][2] = w0.z; wv[jj][3] = w0.w; wv[jj][4] = w1.x; wv[jj][5] = w1.y; wv[jj][6] = w1.z; wv[jj][7] = w1.w; }
            { const f32x4 b0 = *(const f32x4*)(conv_b + j * 1280 + chan), b1 = *(const f32x4*)(conv_b + j * 1280 + chan + 4);
              bv[0] = b0.x; bv[1] = b0.y; bv[2] = b0.z; bv[3] = b0.w; bv[4] = b1.x; bv[5] = b1.y; bv[6] = b1.z; bv[7] = b1.w; }
            unsigned pk[8][2];
            float r0[8], r1[8], r2[8], vp[8];
            unpack8(raw[0], r0); unpack8(raw[1], r1); unpack8(raw[2], r2);
#pragma unroll
            for (int tk = 0; tk < 4; ++tk) {
                float r3[8], v[8];
                unpack8(raw[tk + 3], r3);
#pragma unroll
                for (int e = 0; e < 8; ++e) { const float xx = bv[e] + wv[0][e] * r0[e] + wv[1][e] * r1[e] + wv[2][e] * r2[e] + wv[3][e] * r3[e]; v[e] = xx * __builtin_amdgcn_rcpf(1.f + __expf(-xx)); }
                const int k = 8 * run + 4 * th + tk;
                if (a == 1) { *(LAS u32x4*)(rb + 9216 + (k * 72 + cgp * 8) * 2) = pack8(v); const float wk = __expf(racs_last - racs[k]) * rdts[k];
#pragma unroll
                    for (int e = 0; e < 8; ++e) v[e] *= wk; }
                else if (a == 2) *(LAS u32x4*)(rb + (k * 72 + cgp * 8) * 2) = pack8(v);
                if (tk & 1) {
#pragma unroll
                    for (int e = 0; e < 8; ++e) pk[e][tk >> 1] = cvt_pk_bf16(vp[e], v[e]);
                } else {
#pragma unroll
                    for (int e = 0; e < 8; ++e) vp[e] = v[e];
                }
#pragma unroll
                for (int e = 0; e < 8; ++e) { r0[e] = r1[e]; r1[e] = r2[e]; r2[e] = r3[e]; }
                asm volatile("" ::: "memory");
            }
            const int k0r = 8 * run, tpos = ((k0r & 32) | ((k0r & 8) << 1) | ((k0r & 16) >> 2)) + 8 * th;
            if (a < 2) { LAS unsigned char* dstT = rb + (a == 0 ? 27648 : 18432);
#pragma unroll
                for (int e = 0; e < 8; ++e) *(LAS u32x2*)(dstT + ((cgp * 8 + e) * 72 + tpos) * 2) = (u32x2){pk[e][0], pk[e][1]}; }
        }
        if (i + 1 < nch) SSD_ISSUE(i + 1);
        LDS_BARRIER();
        const int q = 16 * wq + l15; const float acs_q = acss[q];
        unsigned mp[4][2];
        {
            bf16x8 cf[2];
#pragma unroll
            for (int kk = 0; kk < 2; ++kk) cf[kk] = lds_frag(Cs + (q * 72 + 32 * kk + lq * 8) * 2);
#pragma unroll
            for (int ni = 0; ni < 4; ++ni) { f32x4 gt = {0.f, 0.f, 0.f, 0.f};
#pragma unroll
                for (int kk = 0; kk < 2; ++kk) gt = MFMA16(lds_frag(Bs + ((16 * ni + l15) * 72 + 32 * kk + lq * 8) * 2), cf[kk], gt);
                float mv[4];
#pragma unroll
                for (int jj = 0; jj < 4; ++jj) { const int k = 16 * ni + 4 * lq + jj; const bool ok = dir == 0 ? (k <= q) : (k >= q);
                    mv[jj] = ok ? gt[jj] * __expf(acs_q - acss[k]) * dts[k] : 0.f; }
                mp[ni][0] = cvt_pk_bf16(mv[0], mv[1]); mp[ni][1] = cvt_pk_bf16(mv[2], mv[3]); }
        }
        {
            bf16x8 mf[2], cf[2];
#pragma unroll
            for (int kk = 0; kk < 2; ++kk) { mf[kk] = __builtin_bit_cast(bf16x8, (u32x4){mp[2 * kk][0], mp[2 * kk][1], mp[2 * kk + 1][0], mp[2 * kk + 1][1]}); cf[kk] = lds_frag(Cs + (q * 72 + 32 * kk + lq * 8) * 2); }
            const float eq = __expf(acs_q); const int qpos = (q & 32) | ((q & 12) << 1) | ((q & 16) >> 2) | (q & 3);
#pragma unroll
            for (int ni = 0; ni < 4; ++ni) { f32x4 yd = {0.f, 0.f, 0.f, 0.f}, yo = yd;
#pragma unroll
                for (int kk = 0; kk < 2; ++kk) { yd = MFMA16(lds_frag(XTs + ((16 * ni + l15) * 72 + 32 * kk + lq * 8) * 2), mf[kk], yd);
                                                 yo = MFMA16(lds_frag(Hs + ((16 * ni + l15) * 72 + 32 * kk + lq * 8) * 2), cf[kk], yo); }
                float yv[4];
#pragma unroll
                for (int jj = 0; jj < 4; ++jj) { yv[jj] = yd[jj] + eq * yo[jj];
                    if (dir == 0) yv[jj] += Dh * bf2f(*(const LAS unsigned short*)(XTs + ((16 * ni + 4 * lq + jj) * 72 + qpos) * 2)); }
                u32x2 w; w.x = cvt_pk_bf16(yv[0], yv[1]); w.y = cvt_pk_bf16(yv[2], yv[3]);
                *(u32x2*)(Y + (size_t)(tb + q) * D + h * 64 + 16 * ni + 4 * lq) = w; }
        }
        {
            const float decay = __expf(acs_last);
            bf16x8 xf[2];
#pragma unroll
            for (int kk = 0; kk < 2; ++kk) xf[kk] = lds_frag(XTs + ((16 * wq + l15) * 72 + 32 * kk + lq * 8) * 2);
#pragma unroll
            for (int ni = 0; ni < 4; ++ni) { Hacc[ni] = Hacc[ni] * decay;
#pragma unroll
                for (int kk = 0; kk < 2; ++kk) Hacc[ni] = MFMA16(xf[kk], lds_frag(BTw + ((16 * ni + l15) * 72 + 32 * kk + lq * 8) * 2), Hacc[ni]); }
        }
        if (i + 1 < nch) SSD_PREP(buf ^ 1);
    }
#undef SSD_ISSUE
#undef SSD_PREP
    if (!sample) {
        float* o = (dir == 0 ? out_f : out_b) + ((size_t)(bidx * 2 + j) * 16 + h) * 4096;
#pragma unroll
        for (int ni = 0; ni < 4; ++ni)
#pragma unroll
            for (int jj = 0; jj < 4; ++jj) o[(16 * wq + lq * 4 + jj) * 64 + 16 * ni + l15] = Hacc[ni][jj];
    }
}

__device__ __forceinline__ void lru_unit(LAS unsigned char* lds, const bf16_t* P1, int seqrow0, int Lseq, int bidx, bool sample, int kb, int jo, const bf16_t* LRUW,
                                         const float* conv_w, const float* conv_b, const float* ba, const float* bx, const float* lam,
                                         const float* st_f, const float* st_b, float* out_f, float* out_b, bf16_t* YF, bf16_t* YB) {
    const int tid = opaque_tid(), wave = __builtin_amdgcn_readfirstlane(tid >> 6), lane = tid & 63, dir = wave >> 2, wq = wave & 3, tg = tid & 255, l15 = lane & 15, lq = lane >> 4;
    LAS unsigned char* base = lds + dir * 65536;
    LAS unsigned char* XC = base, *WA = base + 9216, *WX = base + 18432;
    LAS float* As = (LAS float*)(base + 27648); LAS float* Us = (LAS float*)(base + 44288);
    LDS_BARRIER();
#pragma unroll
    for (int which = 0; which < 2; ++which) {
        const bf16_t* src = LRUW + ((size_t)((jo * 2 + dir) * 2 + which) * 16 + kb) * 4096;
        LAS unsigned char* dst = which == 0 ? WA : WX;
#pragma unroll
        for (int it = 0; it < 2; ++it) { const int idx = it * 256 + tg, r = idx >> 3, cc = idx & 7;
            *(LAS u32x4*)(dst + (r * 72 + cc * 8) * 2) = *(const u32x4*)(src + r * 64 + cc * 8); }
    }
    float bav[4], bxv[4], spl[4];
#pragma unroll
    for (int ni = 0; ni < 4; ++ni) { const int ch = kb * 64 + 16 * ni + l15; bav[ni] = ba[(jo * 2 + dir) * 1024 + ch]; bxv[ni] = bx[(jo * 2 + dir) * 1024 + ch]; spl[ni] = -8.f * softplusf_(-lam[(jo * 2 + dir) * 1024 + ch]); }
    float hst = 0.f;
    if (sample && tg < 64) hst = (dir == 0 ? st_f : st_b)[(size_t)(bidx * 2 + jo) * 1024 + kb * 64 + tg];
    bf16_t* Y = dir == 0 ? YF : YB;
    const int ntile = Lseq >> 6;
    u32x4 rawl[2][4];
#define LRU_ISSUE(ti) do { const int c_ = dir == 0 ? (ti) : ntile - 1 - (ti); const int tb_ = seqrow0 + 64 * c_; \
        _Pragma("unroll") for (int it = 0; it < 2; ++it) { const int idx = it * 256 + tg, k = idx >> 3, cgp = idx & 7; const int tl = tb_ + k - seqrow0; \
            _Pragma("unroll") for (int jj = 0; jj < 4; ++jj) { const int tt = tl - 2 + jj; \
                rawl[it][jj] = (tt >= 0 && tt < Lseq) ? *(const u32x4*)(P1 + (size_t)(seqrow0 + tt) * 2048 + 1024 + kb * 64 + cgp * 8) : (u32x4){0u, 0u, 0u, 0u}; } } } while (0)
    LRU_ISSUE(0);
    f32x4 cwv[4][2], cbv[2];
    { const int chan = kb * 64 + (tg & 7) * 8;
#pragma unroll
      for (int jj = 0; jj < 4; ++jj) { const float* wp = conv_w + (size_t)(jo * 4 + jj) * 1024 + chan; cwv[jj][0] = *(const f32x4*)wp; cwv[jj][1] = *(const f32x4*)(wp + 4); }
      cbv[0] = *(const f32x4*)(conv_b + jo * 1024 + chan); cbv[1] = *(const f32x4*)(conv_b + jo * 1024 + chan + 4); }
    for (int i = 0; i < ntile; ++i) {
        const int c = dir == 0 ? i : ntile - 1 - i; const int tb = seqrow0 + 64 * c;
        LDS_BARRIER();
#pragma unroll
        for (int it = 0; it < 2; ++it) {
            const int idx = it * 256 + tg, k = idx >> 3, cgp = idx & 7;
            float av[8];
            av[0] = cbv[0].x; av[1] = cbv[0].y; av[2] = cbv[0].z; av[3] = cbv[0].w; av[4] = cbv[1].x; av[5] = cbv[1].y; av[6] = cbv[1].z; av[7] = cbv[1].w;
#pragma unroll
            for (int jj = 0; jj < 4; ++jj) { float r[8]; unpack8(rawl[it][jj], r);
                    const f32x4 w0 = cwv[jj][0], w1 = cwv[jj][1];
                    av[0] += w0.x * r[0]; av[1] += w0.y * r[1]; av[2] += w0.z * r[2]; av[3] += w0.w * r[3]; av[4] += w1.x * r[4]; av[5] += w1.y * r[5]; av[6] += w1.z * r[6]; av[7] += w1.w * r[7]; }
            *(LAS u32x4*)(XC + (k * 72 + cgp * 8) * 2) = pack8(av);
        }
        if (i + 1 < ntile) LRU_ISSUE(i + 1);
        LDS_BARRIER();
        {
            bf16x8 xf[2];
#pragma unroll
            for (int kk = 0; kk < 2; ++kk) xf[kk] = lds_frag(XC + ((16 * wq + l15) * 72 + 32 * kk + lq * 8) * 2);
#pragma unroll
            for (int ni = 0; ni < 4; ++ni) { f32x4 ra = {0.f, 0.f, 0.f, 0.f}, ri = ra;
#pragma unroll
                for (int kk = 0; kk < 2; ++kk) { ra = MFMA16(xf[kk], lds_frag(WA + ((16 * ni + l15) * 72 + 32 * kk + lq * 8) * 2), ra);
                                                 ri = MFMA16(xf[kk], lds_frag(WX + ((16 * ni + l15) * 72 + 32 * kk + lq * 8) * 2), ri); }
#pragma unroll
                for (int jj = 0; jj < 4; ++jj) { const int tok = 16 * wq + 4 * lq + jj, ch = 16 * ni + l15;
                    const float r = __builtin_amdgcn_rcpf(1.f + __expf(-(ra[jj] + bav[ni]))), ig = __builtin_amdgcn_rcpf(1.f + __expf(-(ri[jj] + bxv[ni])));
                    const float log_a = spl[ni] * r; const float a = __expf(log_a);
                    const float xc = bf2f(*(const LAS unsigned short*)(XC + (tok * 72 + ch) * 2));
                    const float uu = __builtin_amdgcn_sqrtf(fmaxf(1.f - a * a, 0.f)) * (ig * xc);
                    As[tok * 65 + ch] = a; Us[tok * 65 + ch] = uu; }
            }
        }
        LDS_BARRIER();
        if (tg < 64) {
#pragma unroll 8
            for (int s = 0; s < 64; ++s) { const int tok = dir == 0 ? s : 63 - s;
                hst = As[tok * 65 + tg] * hst + Us[tok * 65 + tg];
                Us[tok * 65 + tg] = hst; }
        }
        LDS_BARRIER();
#pragma unroll
        for (int it = 0; it < 2; ++it) { const int idx = it * 256 + tg, tok = idx >> 3, c8 = idx & 7; float o[8];
#pragma unroll
            for (int e = 0; e < 8; ++e) o[e] = Us[tok * 65 + c8 * 8 + e];
            *(u32x4*)(Y + (size_t)(tb + tok) * D + kb * 64 + c8 * 8) = pack8(o); }
    }
#undef LRU_ISSUE
    if (!sample && tg < 64) (dir == 0 ? out_f : out_b)[(size_t)(bidx * 2 + jo) * 1024 + kb * 64 + tg] = hst;
}

__device__ __forceinline__ void attn_unit(LAS unsigned char* lds, const bf16_t* P1, const bf16_t* cacheK, const bf16_t* cacheV, int seqrow0, int nkc, int nkn, int qrow, int h,
                                          const float* lp, float lam_init, const float* sub_g, bf16_t* A2) {
    const int tid = opaque_tid(), wave = __builtin_amdgcn_readfirstlane(tid >> 6), lane = tid & 63, comp = wave >> 2, wq = wave & 3, l15 = lane & 15, lq = lane >> 4;
    LAS unsigned char* Ks = lds; LAS unsigned char* VT = lds + 17408; LAS unsigned char* Pw = lds + 35840 + wave * 4608; LAS float* O1 = (LAS float*)(lds + 73728);
    bf16x8 qf[2][2];
    {
        const bf16_t* qb = P1 + (size_t)(qrow + 32 * wq) * NIN_E + COL_Q + h * 128 + comp * 64;
#pragma unroll
        for (int mi = 0; mi < 2; ++mi)
#pragma unroll
            for (int kk = 0; kk < 2; ++kk) qf[mi][kk] = *(const bf16x8*)(qb + (size_t)(16 * mi + l15) * NIN_E + 32 * kk + lq * 8);
    }
    float m_run[2] = {-1e30f, -1e30f}, l_run[2] = {0.f, 0.f};
    f32x4 oT[2][8];
#pragma unroll
    for (int mi = 0; mi < 2; ++mi)
#pragma unroll
        for (int ei = 0; ei < 8; ++ei) oT[mi][ei] = (f32x4){0.f, 0.f, 0.f, 0.f};
    const int ntile = (nkc + nkn) >> 6;
    const int sk = tid >> 3, sc0 = (tid & 7) * 16;
    const int vkey = tid & 63, vc0 = (tid >> 6) * 16, vpos = (vkey & 32) | ((vkey & 12) << 1) | ((vkey & 16) >> 2) | (vkey & 3);
    u32x4 pk0, pk1, pv0, pv1;
#define ATT_PREFETCH(T) do { const int key0_ = (T) * 64; \
        const bf16_t* kp_ = key0_ < nkc ? cacheK + (size_t)(key0_ + sk) * 1024 + h * 128 + sc0 : P1 + (size_t)(seqrow0 + key0_ - nkc + sk) * NIN_E + COL_K + h * 128 + sc0; \
        const bf16_t* vp_ = key0_ < nkc ? cacheV + (size_t)(key0_ + vkey) * 1024 + h * 128 + vc0 : P1 + (size_t)(seqrow0 + key0_ - nkc + vkey) * NIN_E + COL_V + h * 128 + vc0; \
        pk0 = *(const u32x4*)kp_; pk1 = *(const u32x4*)(kp_ + 8); pv0 = *(const u32x4*)vp_; pv1 = *(const u32x4*)(vp_ + 8); } while (0)
    ATT_PREFETCH(0);
    for (int tile = 0; tile < ntile; ++tile) {
        LDS_BARRIER();
        {
            *(LAS u32x4*)(Ks + (sk * 136 + sc0) * 2) = pk0; *(LAS u32x4*)(Ks + (sk * 136 + sc0 + 8) * 2) = pk1;
            const unsigned vw[8] = {pv0.x, pv0.y, pv0.z, pv0.w, pv1.x, pv1.y, pv1.z, pv1.w};
#pragma unroll
            for (int e = 0; e < 8; ++e) { *(LAS unsigned short*)(VT + ((vc0 + 2 * e) * 72 + vpos) * 2) = (unsigned short)(vw[e] & 0xffffu); *(LAS unsigned short*)(VT + ((vc0 + 2 * e + 1) * 72 + vpos) * 2) = (unsigned short)(vw[e] >> 16); }
        }
        LDS_BARRIER();
        if (tile + 1 < ntile) ATT_PREFETCH(tile + 1);
        f32x4 st[2][4];
#pragma unroll
        for (int ni = 0; ni < 4; ++ni) {
            bf16x8 kf[2];
#pragma unroll
            for (int kk = 0; kk < 2; ++kk) kf[kk] = lds_frag(Ks + ((16 * ni + l15) * 136 + comp * 64 + 32 * kk + lq * 8) * 2);
#pragma unroll
            for (int mi = 0; mi < 2; ++mi) { f32x4 s = {0.f, 0.f, 0.f, 0.f};
#pragma unroll
                for (int kk = 0; kk < 2; ++kk) s = MFMA16(kf[kk], qf[mi][kk], s);
                st[mi][ni] = s; }
        }
        float mnew[2]; bool changed = false;
#pragma unroll
        for (int mi = 0; mi < 2; ++mi) {
            float mx = -1e30f;
#pragma unroll
            for (int ni = 0; ni < 4; ++ni)
#pragma unroll
                for (int jj = 0; jj < 4; ++jj) mx = fmaxf(mx, st[mi][ni][jj]);
            mx = x16_max(mx); mx = x32_max(mx);
            mnew[mi] = mx > m_run[mi] + 8.f ? mx : m_run[mi];
            changed = changed || (mnew[mi] != m_run[mi]);
        }
        if (__builtin_amdgcn_ballot_w64(changed) != 0ull) {
#pragma unroll
            for (int mi = 0; mi < 2; ++mi) { const float alpha = __builtin_amdgcn_exp2f(m_run[mi] - mnew[mi]); m_run[mi] = mnew[mi]; l_run[mi] *= alpha;
#pragma unroll
                for (int ei = 0; ei < 8; ++ei) oT[mi][ei] = oT[mi][ei] * alpha; }
        }
        unsigned pp[2][4][2];
#pragma unroll
        for (int mi = 0; mi < 2; ++mi) {
            float ls = 0.f;
#pragma unroll
            for (int ni = 0; ni < 4; ++ni) { float pv[4];
#pragma unroll
                for (int jj = 0; jj < 4; ++jj) { pv[jj] = __builtin_amdgcn_exp2f(st[mi][ni][jj] - m_run[mi]); ls += pv[jj]; }
                pp[mi][ni][0] = cvt_pk_bf16(pv[0], pv[1]); pp[mi][ni][1] = cvt_pk_bf16(pv[2], pv[3]); }
            l_run[mi] += ls;
        }
#pragma unroll
        for (int kk = 0; kk < 2; ++kk) {
            bf16x8 pa[2];
#pragma unroll
            for (int mi = 0; mi < 2; ++mi) pa[mi] = __builtin_bit_cast(bf16x8, (u32x4){pp[mi][2 * kk][0], pp[mi][2 * kk][1], pp[mi][2 * kk + 1][0], pp[mi][2 * kk + 1][1]});
#pragma unroll
            for (int ei = 0; ei < 8; ++ei) { const bf16x8 vb = lds_frag(VT + ((16 * ei + l15) * 72 + 32 * kk + lq * 8) * 2);
#pragma unroll
                for (int mi = 0; mi < 2; ++mi) oT[mi][ei] = MFMA16(vb, pa[mi], oT[mi][ei]); }
        }
        CBAR();
    }
#pragma unroll
    for (int mi = 0; mi < 2; ++mi) { float l = l_run[mi]; l = x16_sum(l); l = x32_sum(l); const float inv = 1.f / l;
#pragma unroll
        for (int ei = 0; ei < 8; ++ei) oT[mi][ei] = oT[mi][ei] * inv; }
#undef ATT_PREFETCH
    const float lam = __expf(wave_sum(lp[lane] * lp[64 + lane], lane)) - __expf(wave_sum(lp[128 + lane] * lp[192 + lane], lane)) + lam_init;
    const float oscale = 1.f - lam_init;
    if (comp == 1) {
#pragma unroll
        for (int mi = 0; mi < 2; ++mi)
#pragma unroll
            for (int ei = 0; ei < 8; ++ei) *(LAS f32x4*)(O1 + (32 * wq + 16 * mi + l15) * 132 + 16 * ei + 4 * lq) = oT[mi][ei];
    }
    __syncthreads();
    if (comp == 0) {
#pragma unroll
        for (int mi = 0; mi < 2; ++mi) { float ss = 0.f;
#pragma unroll
            for (int ei = 0; ei < 8; ++ei) { const f32x4 o1 = *(const LAS f32x4*)(O1 + (32 * wq + 16 * mi + l15) * 132 + 16 * ei + 4 * lq); const f32x4 o = oT[mi][ei] - o1 * lam; oT[mi][ei] = o;
                ss += (o.x * o.x + o.y * o.y) + (o.z * o.z + o.w * o.w); }
            ss = x16_sum(ss); ss = x32_sum(ss);
            const float rstd = rsqrtf(ss * (1.f / 128.f) + EPS) * oscale;
            bf16_t* op = A2 + (size_t)(qrow + 32 * wq + 16 * mi + l15) * 2048 + 1024 + h * 128 + 4 * lq;
#pragma unroll
            for (int ei = 0; ei < 8; ++ei) { const f32x4 gsub = *(const f32x4*)(sub_g + 16 * ei + 4 * lq); const f32x4 o = oT[mi][ei] * rstd * gsub;
                u32x2 w; w.x = cvt_pk_bf16(o.x, o.y); w.y = cvt_pk_bf16(o.z, o.w); *(u32x2*)(op + 16 * ei) = w; }
        }
    }
}

__device__ __forceinline__ int opaque_idx(int i) { asm volatile("" : "+s"(i)); return i; }
__device__ __forceinline__ GAS unsigned char* opaque_ptr(GAS unsigned char* q) { asm volatile("" : "+s"(q)); return q; }
#define x_prompt ((const float*)p.in[opaque_idx(0)])
#define x_sample ((const float*)p.in[opaque_idx(1)])
#define cvec ((const float*)p.in[opaque_idx(2)])
#define cache_k ((const float*)p.in[opaque_idx(3)])
#define cache_v ((const float*)p.in[opaque_idx(4)])
#define st_ssd_f ((const float*)p.in[opaque_idx(5)])
#define st_ssd_b ((const float*)p.in[opaque_idx(6)])
#define st_lru_f ((const float*)p.in[opaque_idx(7)])
#define st_lru_b ((const float*)p.in[opaque_idx(8)])
#define c_ctx ((const float*)p.in[opaque_idx(9)])
#define w_mod ((const float*)p.in[opaque_idx(10)])
#define b_mod ((const float*)p.in[opaque_idx(11)])
#define norm_mix_g ((const float*)p.in[opaque_idx(12)])
#define norm_ffn_g ((const float*)p.in[opaque_idx(13)])
#define w_in_e ((const float*)p.in[opaque_idx(14)])
#define ssd_conv_w ((const float*)p.in[opaque_idx(15)])
#define ssd_conv_b ((const float*)p.in[opaque_idx(16)])
#define ssd_a_log ((const float*)p.in[opaque_idx(17)])
#define ssd_dt_bias ((const float*)p.in[opaque_idx(18)])
#define ssd_d ((const float*)p.in[opaque_idx(19)])
#define ssd_norm_g ((const float*)p.in[opaque_idx(20)])
#define diff_lambda ((const float*)p.in[opaque_idx(21)])
#define diff_norm_g ((const float*)p.in[opaque_idx(22)])
#define w_out_e ((const float*)p.in[opaque_idx(23)])
#define lru_w_in ((const float*)p.in[opaque_idx(24)])
#define lru_conv_w ((const float*)p.in[opaque_idx(25)])
#define lru_conv_b ((const float*)p.in[opaque_idx(26)])
#define lru_wa ((const float*)p.in[opaque_idx(27)])
#define lru_ba ((const float*)p.in[opaque_idx(28)])
#define lru_wx ((const float*)p.in[opaque_idx(29)])
#define lru_bx ((const float*)p.in[opaque_idx(30)])
#define lru_lambda ((const float*)p.in[opaque_idx(31)])
#define lru_w_out ((const float*)p.in[opaque_idx(32)])
#define ffn_w_up ((const float*)p.in[opaque_idx(33)])
#define ffn_conv_w ((const float*)p.in[opaque_idx(34)])
#define ffn_conv_b ((const float*)p.in[opaque_idx(35)])
#define ffn_w_down ((const float*)p.in[opaque_idx(36)])
#define final_norm_g ((const float*)p.in[opaque_idx(37)])
#define WSB ((unsigned char*)opaque_ptr(p.ws))
#define OUTB ((float*)opaque_ptr((GAS unsigned char*)p.out))
#define X OUTB
#define outK (OUTB + 16777216)
#define outV (OUTB + 2 * 16777216)
#define outSF (OUTB + 3 * 16777216)
#define outSB (OUTB + 3 * 16777216 + 4194304)
#define outLF (OUTB + 3 * 16777216 + 2 * 4194304)
#define outLB (OUTB + 3 * 16777216 + 2 * 4194304 + 65536)
#define ROPE ((float*)(WSB + WS_ROPE))
#define MOD ((float*)(WSB + WS_MOD))
#define LRUW ((bf16_t*)(WSB + WS_LRUW))
#define DTB ((float*)(WSB + WS_DT))
#define WIN_E ((bf16_t*)(WSB + WS_WIN_E))
#define WOUT_E ((bf16_t*)(WSB + WS_WOUT_E))
#define WIN_O ((bf16_t*)(WSB + WS_WIN_O))
#define WOUT_O ((bf16_t*)(WSB + WS_WOUT_O))
#define WUP ((bf16_t*)(WSB + WS_WUP))
#define WDN ((bf16_t*)(WSB + WS_WDN))
#define HBF ((bf16_t*)(WSB + WS_HBF))
#define YF ((bf16_t*)(WSB + WS_YF))
#define YB ((bf16_t*)(WSB + WS_YB))
#define P1 ((bf16_t*)(WSB + WS_P1))
#define A2 ((bf16_t*)(WSB + WS_A2))
#define SBB ((float*)(WSB + WS_SB))
#define PARTB ((float*)(WSB + WS_PART))
#define KCB ((bf16_t*)(WSB + WS_A2 + 64 * MiB))
__global__ void __launch_bounds__(512, 2) mega_fwd(Params p) {
    extern __shared__ __attribute__((aligned(16))) unsigned char lds_raw[];
    LAS unsigned char* lds = (LAS unsigned char*)lds_raw;
    cg::grid_group grid = cg::this_grid();
    { volatile LAS unsigned* st_ = (volatile LAS unsigned*)(lds + LDS_BYTES - 16); if (threadIdx.x < 2) st_[threadIdx.x] = 0u; }
    __syncthreads();
    if (blockIdx.x == 0) { unsigned* bw_ = (unsigned*)((unsigned char*)p.ws + WS_BAR); for (int i = threadIdx.x; i < XCD_BAR_WORDS; i += 512) __hip_atomic_store(bw_ + i, 0u, __ATOMIC_RELAXED, __HIP_MEMORY_SCOPE_AGENT); }
    const int G = gridDim.x, bx = blockIdx.x;
    const int vbx = (G % 8 == 0) ? (bx % 8) * (G / 8) + bx / 8 : bx;
    for (int rep = 0; rep < REP_P0; ++rep) {
        __syncthreads();
        const int tid = opaque_tid(), lane = tid & 63, wave = __builtin_amdgcn_readfirstlane(tid >> 6);
        const int gw = bx * 8 + wave, NGW = G * 8, gtid = bx * 512 + tid, nthreads = G * 512;
        LAS float* scr = (LAS float*)(lds + wave * 16384);
        constexpr int I_WIN_E = 16 * 169, I_WOUT_E = 32 * 32, I_WIN_O = 16 * 64, I_WOUT_O = 16 * 32, I_WUP = 16 * 176, I_WDN = 44 * 32;
        constexpr int NITEMS = 2 * I_WIN_E + 2 * I_WOUT_E + 2 * I_WIN_O + 2 * I_WOUT_O + 4 * I_WUP + 4 * I_WDN;
        for (int it = gw; it < NITEMS; it += NGW) {
            int r = it;
            if (r < 2 * I_WIN_E) { const int j = r / I_WIN_E; transpose_item(w_in_e + (size_t)j * 1024 * 5408, 1024, 5408, WIN_E + (size_t)j * NIN_E * 1024, 2336, 224, scr, r % I_WIN_E, lane); continue; } r -= 2 * I_WIN_E;
            if (r < 2 * I_WOUT_E) { const int j = r / I_WOUT_E; transpose_item(w_out_e + (size_t)j * 2048 * 1024, 2048, 1024, WOUT_E + (size_t)j * 1024 * 2048, 1 << 30, 0, scr, r % I_WOUT_E, lane); continue; } r -= 2 * I_WOUT_E;
            if (r < 2 * I_WIN_O) { const int j = r / I_WIN_O; transpose_item(lru_w_in + (size_t)j * 1024 * 2048, 1024, 2048, WIN_O + (size_t)j * 2048 * 1024, 1 << 30, 0, scr, r % I_WIN_O, lane); continue; } r -= 2 * I_WIN_O;
            if (r < 2 * I_WOUT_O) { const int j = r / I_WOUT_O; transpose_item(lru_w_out + (size_t)j * 1024 * 1024, 1024, 1024, WOUT_O + (size_t)j * 1024 * 1024, 1 << 30, 0, scr, r % I_WOUT_O, lane); continue; } r -= 2 * I_WOUT_O;
            if (r < 4 * I_WUP) { const int l = r / I_WUP; transpose_item(ffn_w_up + (size_t)l * 1024 * 5632, 1024, 5632, WUP + (size_t)l * 5632 * 1024, -1, 0, scr, r % I_WUP, lane); continue; } r -= 4 * I_WUP;
            { const int l = r / I_WDN; transpose_item(ffn_w_down + (size_t)l * 2816 * 1024, 2816, 1024, WDN + (size_t)l * 1024 * 2816, 1 << 30, 0, scr, r % I_WDN, lane); }
        }
        for (int i = gtid; i < 2 * 224 * 128; i += nthreads) { const int j = i / (224 * 128), r = (i / 128) % 224, cc = i % 128;
            *(u32x4*)(WIN_E + ((size_t)j * NIN_E + 2336 + r) * 1024 + cc * 8) = (u32x4){0u, 0u, 0u, 0u}; }
        for (int i = gtid; i < 524288; i += nthreads) { const int k = i & 63, jj = (i >> 6) & 63, blk = (i >> 12) & 15, which = (i >> 16) & 1, ld = i >> 17;
            const float* src = which == 0 ? lru_wa : lru_wx; LRUW[i] = f2bf(src[((size_t)ld * 16 + blk) * 4096 + k * 64 + jj]); }
        if (bx == 0) { for (int i = tid; i < 1024; i += 512) { const int pos = i >> 4, fi = i & 15; const float fr = powf(10000.f, -(float)(2 * fi) / 32.f); const float ang = (float)pos * fr;
            ROPE[i] = cosf(ang); ROPE[1024 + i] = sinf(ang); } }
        __syncthreads();
        LAS float* sv = (LAS float*)lds;
        LAS float* red = (LAS float*)(lds + 36864);
        bool sv_ready = false;
        for (int unit = bx; unit < 4 * 96; unit += G) {
            if (!sv_ready) { for (int i = tid; i < 9 * 1024; i += 512) { const int ci = i >> 10, k = i & 1023; const float cvv = ci == 0 ? c_ctx[k] : cvec[(ci - 1) * 1024 + k]; sv[i] = siluf_(cvv); } sv_ready = true; }
            __syncthreads();
            const int l = unit / 96, nb = unit % 96, col = nb * 64 + lane;
            float acc9[9];
#pragma unroll
            for (int ci = 0; ci < 9; ++ci) acc9[ci] = 0.f;
            const float* wp = w_mod + ((size_t)l * 1024 + wave * 128) * 6144 + col;
#pragma unroll 4
            for (int k4 = 0; k4 < 32; ++k4) {
                const float w0 = wp[(size_t)(4 * k4) * 6144], w1 = wp[(size_t)(4 * k4 + 1) * 6144], w2 = wp[(size_t)(4 * k4 + 2) * 6144], w3 = wp[(size_t)(4 * k4 + 3) * 6144];
#pragma unroll
                for (int ci = 0; ci < 9; ++ci) { const f32x4 s4 = *(const LAS f32x4*)(sv + ci * 1024 + wave * 128 + 4 * k4); acc9[ci] += (s4.x * w0 + s4.y * w1) + (s4.z * w2 + s4.w * w3); }
            }
#pragma unroll
            for (int ci = 0; ci < 9; ++ci) red[(wave * 9 + ci) * 64 + lane] = acc9[ci];
            __syncthreads();
            for (int e = tid; e < 576; e += 512) { const int ci = e >> 6, ln = e & 63; float s = 0.f;
#pragma unroll
                for (int w = 0; w < 8; ++w) s += red[(w * 9 + ci) * 64 + ln];
                MOD[((size_t)l * 9 + ci) * 6144 + nb * 64 + ln] = s + b_mod[l * 6144 + nb * 64 + ln]; }
        }
    }
    CG_SYNC();
    (void)xcd_barrier_post((unsigned*)((unsigned char*)p.ws + WS_BAR), (volatile LAS unsigned*)(lds + LDS_BYTES - 16));
    first_rows(x_prompt, x_sample, X, norm_mix_g, MOD, HBF, PARTB);
    cache_to_bf16(cache_k, cache_v, 0, KCB);
    for (int jj = 0; jj < 2; ++jj) { sb_gemv_phase(MOD, WIN_E + (size_t)jj * NIN_E * 1024, NIN_E, 2 * jj, 0, SBB + (size_t)jj * 9 * NIN_E, NIN_E);
                                     sb_gemv_phase(MOD, WIN_O + (size_t)jj * 2048 * 1024, 2048, 2 * jj + 1, 0, SBB + 101376 + (size_t)jj * 18432, 2048); }
    for (int ll = 0; ll < 4; ++ll) sb_gemv_phase(MOD, WUP + (size_t)ll * NFF2 * 1024, NFF2, ll, 3, SBB + 138240 + (size_t)ll * 50688, NFF2);
    GRID_SYNC();

    for (int l = 0; l < 4; ++l) {
        const int j = l >> 1;
#define mod_l (MOD + (size_t)l * 9 * 6144)
        if ((l & 1) == 0) {
            {
                pg8::Gemm g{HBF, WIN_E + (size_t)j * NIN_E * 1024, NTOK, NIN_E, 1024}; pg8::StaticOrder S; S.init(NTOK, NIN_E, G, bx);
                if (l == 2) cache_to_bf16(cache_k, cache_v, 1, KCB);
                EpiInEven E{P1, DTB, outK, outV, ROPE, j, PARTB, SBB + (size_t)j * 9 * NIN_E};
                for (int rep = 0; rep < REP_GP; ++rep) pg8::gemm_phase<EpiInEven, pg8::StaticOrder, true, true>(lds, g, S, E);
            }
            GRID_SYNC();
            if (STOP_AT == 1) return;
            {
                for (int rep = 0; rep < REP_SSD; ++rep)
                for (int bun = vbx; bun < 256; bun += G) {
                    if (!EN_SSD) break;
                    if (bun < 128) { const int b = bun >> 4, h = bun & 15;
                        ssd_unit(lds, P1, DTB, NPROMPT + b * 1024, 1024, b, true, h, j, ssd_conv_w, ssd_conv_b, ssd_a_log, ssd_dt_bias, ssd_d, st_ssd_f, st_ssd_b, outSF, outSB, YF, YB);
                    } else { for (int q4 = 0; q4 < 4; ++q4) { const int u = (bun - 128) * 4 + q4, b = u >> 4, h = u & 15;
                        ssd_unit(lds, P1, DTB, b * 256, 256, b, false, h, j, ssd_conv_w, ssd_conv_b, ssd_a_log, ssd_dt_bias, ssd_d, st_ssd_f, st_ssd_b, outSF, outSB, YF, YB); } }
                }
                __syncthreads();
                const float lam_init = (l == 0) ? 0.2f : 0.47071302f;
                for (int rep = 0; rep < REP_ATTN; ++rep)
                for (int bun = vbx; bun < 256; bun += G) {
                    if (!EN_ATTN) break;
                    for (int q2 = 0; q2 < 2; ++q2) { const int u = bun * 2 + q2, qb = u & 7, h = (u >> 3) & 7, b = u >> 6;
                        attn_unit(lds, P1, KCB + (size_t)b * 524288, KCB + 4194304 + (size_t)b * 524288, NPROMPT + b * 1024, 512, 1024, NPROMPT + b * 1024 + qb * 128, h, diff_lambda + j * 256, lam_init, diff_norm_g + j * 128, A2); }
                    for (int q2 = 0; q2 < 2; ++q2) { const int u = bun * 2 + q2, qb = u & 1, h = (u >> 1) & 7, b = u >> 4;
                        attn_unit(lds, P1, nullptr, nullptr, b * 256, 0, 256, b * 256 + qb * 128, h, diff_lambda + j * 256, lam_init, diff_norm_g + j * 128, A2); }
                }
            }
            GRID_SYNC();
            if (STOP_AT == 2) return;
            for (int rep = 0; rep < REP_ELT; ++rep) ssd_gate_phase(YF, YB, P1, ssd_norm_g + j * 1024, A2);
            GRID_SYNC();
            {
                pg8::Gemm g{A2, WOUT_E + (size_t)j * 1024 * 2048, NTOK, 1024, 2048}; pg8::StaticOrder S; S.init(NTOK, 1024, G, bx);
                EpiResid E{X, mod_l + 2 * 1024, HBF, norm_ffn_g + l * 1024, mod_l + 4 * 1024, PARTB + 262144, l == 0 ? x_prompt : (const float*)X, l == 0 ? x_sample : (const float*)X + (size_t)NPROMPT * 1024};
                pg8::gemm_phase<EpiResid, pg8::StaticOrder, false, true>(lds, g, S, E);
            }
            GRID_SYNC();
        } else {
            {
                pg8::Gemm g{HBF, WIN_O + (size_t)j * 2048 * 1024, NTOK, 2048, 1024}; pg8::StaticOrder S; S.init(NTOK, 2048, G, bx);
                EpiScaledBf16 E{P1, 2048, PARTB, SBB + 101376 + (size_t)j * 18432};
                for (int rep = 0; rep < REP_GP; ++rep) pg8::gemm_phase<EpiScaledBf16, pg8::StaticOrder, true, true>(lds, g, S, E);
            }
            GRID_SYNC();
            for (int rep = 0; rep < REP_LRU; ++rep)
            for (int bun = vbx; bun < 256; bun += G) {
                if (!EN_LRU) break;
                if (bun < 128) { const int b = bun >> 4, kb = bun & 15;
                    lru_unit(lds, P1, NPROMPT + b * 1024, 1024, b, true, kb, j, LRUW, lru_conv_w, lru_conv_b, lru_ba, lru_bx, lru_lambda, st_lru_f, st_lru_b, outLF, outLB, YF, YB);
                } else { for (int q4 = 0; q4 < 4; ++q4) { const int u = (bun - 128) * 4 + q4, b = u >> 4, kb = u & 15;
                    lru_unit(lds, P1, b * 256, 256, b, false, kb, j, LRUW, lru_conv_w, lru_conv_b, lru_ba, lru_bx, lru_lambda, st_lru_f, st_lru_b, outLF, outLB, YF, YB); } }
            }
            GRID_SYNC();
            for (int rep = 0; rep < REP_ELT; ++rep) lru_gate_phase(YF, YB, P1, A2);
            GRID_SYNC();
            {
                pg8::Gemm g{A2, WOUT_O + (size_t)j * 1024 * 1024, NTOK, 1024, 1024}; pg8::StaticOrder S; S.init(NTOK, 1024, G, bx);
                EpiResid E{X, mod_l + 2 * 1024, HBF, norm_ffn_g + l * 1024, mod_l + 4 * 1024, PARTB + 262144, l == 0 ? x_prompt : (const float*)X, l == 0 ? x_sample : (const float*)X + (size_t)NPROMPT * 1024};
                pg8::gemm_phase<EpiResid, pg8::StaticOrder, false, true>(lds, g, S, E);
            }
            GRID_SYNC();
        }
        if (STOP_AT == 3) return;
        {
            pg8::Gemm g{HBF, WUP + (size_t)l * NFF2 * 1024, NTOK, NFF2, 1024}; pg8::StaticOrder S; S.init(NTOK, NFF2, G, bx);
#if FFN_FUSED
            EpiFfnAct E{A2, PARTB + 262144, SBB + 138240 + (size_t)l * 50688, ffn_conv_w + (size_t)l * 3 * NFF2, ffn_conv_b + (size_t)l * NFF2, P1, lds + 131072};
            pg8::gemm_phase<EpiFfnAct, pg8::StaticOrder, true, true>(lds, g, S, E);
#else
            EpiScaledBf16 E{P1, NFF2, PARTB + 262144, SBB + 138240 + (size_t)l * 50688};
            for (int rep = 0; rep < REP_GP; ++rep) pg8::gemm_phase<EpiScaledBf16, pg8::StaticOrder, true, true>(lds, g, S, E);
#endif
        }
        GRID_SYNC();
#if !FFN_FUSED
        for (int rep = 0; rep < REP_ELT; ++rep) ffn_act_phase(P1, ffn_conv_w + (size_t)l * 3 * NFF2, ffn_conv_b + (size_t)l * NFF2, A2);
        GRID_SYNC();
#endif
        {
            pg8::Gemm g{A2, WDN + (size_t)l * 1024 * NFF, NTOK, 1024, NFF}; pg8::StaticOrder S; S.init(NTOK, 1024, G, bx);
#if FFN_FUSED
            for (int ui = 0; ; ++ui) { pg8::Unit uu; if (!S.next(ui, uu)) break; ffn_fix_panel(P1, ffn_conv_w + (size_t)l * 3 * NFF2, ffn_conv_b + (size_t)l * NFF2, A2, uu.pm); }
            asm volatile("s_waitcnt vmcnt(0)" ::: "memory"); __syncthreads();
#endif
            EpiResid E{X, mod_l + 5 * 1024, l < 3 ? HBF : nullptr, norm_mix_g + (size_t)(l < 3 ? l + 1 : l) * 1024, MOD + (size_t)(l < 3 ? l + 1 : l) * 9 * 6144 + 1024, PARTB, (const float*)X, (const float*)X + (size_t)NPROMPT * 1024};
            pg8::gemm_phase<EpiResid, pg8::StaticOrder, false, true>(lds, g, S, E);
        }
        GRID_SYNC();
        if (STOP_AT == 4) return;
    }
    norm_rows<1, false>(nullptr, nullptr, X, final_norm_g, nullptr, 0, nullptr);
}

extern "C" void kernel_launch(void* const* d_in, const int* in_sizes, int n_in, void* d_out, int out_size, void* d_ws, size_t ws_size, hipStream_t stream) {
    static int grid_blocks = 0;
    if (grid_blocks == 0) {
        if (n_in != 38 || ws_size < WS_END) { fprintf(stderr, "kernel_launch: unexpected n_in %d / ws_size %zu\n", n_in, ws_size); grid_blocks = -1; return; }
        int dev = 0, cus = 0, per_cu = 0;
        hipGetDevice(&dev);
        hipDeviceGetAttribute(&cus, hipDeviceAttributeMultiprocessorCount, dev);
        hipFuncSetAttribute((const void*)mega_fwd, hipFuncAttributeMaxDynamicSharedMemorySize, LDS_BYTES);
        hipOccupancyMaxActiveBlocksPerMultiprocessor(&per_cu, (const void*)mega_fwd, 512, LDS_BYTES);
        if (per_cu < 1) { fprintf(stderr, "kernel_launch: occupancy query says %d blocks per CU\n", per_cu); per_cu = 1; }
        if (per_cu > 1) per_cu = 1;
        grid_blocks = cus * per_cu;
        (void)hipGetLastError();
    }
    if (grid_blocks < 0) return;
    Params p{};
    for (int i = 0; i < 38; ++i) p.in[i] = (gcfp)d_in[i];
    p.out = (GAS float*)d_out; p.ws = (GAS unsigned char*)d_ws;
    void* args[] = {&p};
    hipError_t e = hipLaunchCooperativeKernel((const void*)mega_fwd, dim3(grid_blocks), dim3(512), args, LDS_BYTES, stream);
    if (e != hipSuccess) fprintf(stderr, "cooperative launch failed: %s (grid %d)\n", hipGetErrorString(e), grid_blocks);
}
```
